# Optimizing an MI355X kernel written in HIP

```python
import jax, jax.numpy as jnp
from jax import lax
import numpy as np

D_MODEL = 1024
BATCH = 32
SEQ = 256
DEPTH = 1
DEC_BATCH = 4
DEC_SEQ = 4096
PAST_LEN = 512

GRID_W = 64
H_M = 4
DH_M = 128
MLSTM_W = H_M * DH_M
CHUNK = 128
M_INIT = -1e30
H_A = 8
NOPE = 64
ROPE_DIM = 32
V_DIM = 64
Q_LORA = 384
KV_LORA = 256
AX_DIM = ROPE_DIM // 2
ROPE_BASE = 10000.0
Q_BLOCK = 128
D_FF = 4 * D_MODEL
N_MOD = 6
EPS = 1e-6
IN_SIZES = (MLSTM_W, MLSTM_W, MLSTM_W, MLSTM_W, 4 * H_M, Q_LORA, KV_LORA, ROPE_DIM, 2 * D_MODEL)
IN_COLS = 4 * MLSTM_W + 4 * H_M + Q_LORA + KV_LORA + ROPE_DIM + 2 * D_MODEL

kernel_name = "hybrid_mlstm_mla_prefix_diffusion_step"


def rmsnorm(x, w):
    xf = x.astype(jnp.float32)
    y = xf * lax.rsqrt(jnp.mean(xf * xf, axis=-1, keepdims=True) + EPS)
    return (y * w.astype(jnp.float32)).astype(x.dtype)


def axial_rope(n_tokens):
    rows = n_tokens // GRID_W
    row = jnp.broadcast_to(jnp.arange(rows, dtype=jnp.float32)[:, None], (rows, GRID_W)).reshape(-1)
    col = jnp.broadcast_to(jnp.arange(GRID_W, dtype=jnp.float32)[None, :], (rows, GRID_W)).reshape(-1)
    inv = ROPE_BASE ** (-jnp.arange(0, AX_DIM, 2, dtype=jnp.float32) / AX_DIM)
    ang = jnp.concatenate([row[:, None] * inv, col[:, None] * inv], axis=-1)
    return jnp.cos(ang), jnp.sin(ang)


def apply_rope(x, cos, sin):
    x1, x2 = x[..., 0::2], x[..., 1::2]
    cos, sin = cos.astype(x.dtype), sin.astype(x.dtype)
    return jnp.stack([x1 * cos - x2 * sin, x1 * sin + x2 * cos], axis=-1).reshape(x.shape)


def blocked_attention(q, k, v):
    B, T, H, Dq = q.shape
    nb = T // Q_BLOCK
    scale = Dq ** -0.5
    kf, vf = k.astype(jnp.float32), v.astype(jnp.float32)
    qb = jnp.moveaxis(q.reshape(B, nb, Q_BLOCK, H, Dq), 1, 0)

    def one_block(qi):
        s = jnp.einsum('bqhd,bkhd->bhqk', qi.astype(jnp.float32), kf) * scale
        p = jax.nn.softmax(s, axis=-1)
        return jnp.einsum('bhqk,bkhd->bqhd', p, vf)

    o = lax.map(one_block, qb)
    return jnp.moveaxis(o, 0, 1).reshape(B, T, H, v.shape[-1]).astype(q.dtype)


def _to_chunks(a, nc):
    B, T, H = a.shape[:3]
    a = a.astype(jnp.float32).reshape((B, nc, CHUNK, H) + a.shape[3:])
    return jnp.moveaxis(a, (1, 3), (0, 2))


def mlstm_chunkwise(q, k, v, log_i, log_f, C0, n0, m0):
    B, T, H, Dh = q.shape
    nc = T // CHUNK
    xs = (_to_chunks(q, nc), _to_chunks(k, nc), _to_chunks(v, nc), _to_chunks(log_i, nc), _to_chunks(log_f, nc))
    causal = jnp.tril(jnp.ones((CHUNK, CHUNK), dtype=bool))

    def step(carry, inp):
        C, n, m = carry
        qc, kc, vc, ic, fc = inp
        b = jnp.cumsum(fc, axis=-1)
        dmat = jnp.where(causal, b[..., :, None] - b[..., None, :] + ic[..., None, :], -jnp.inf)
        inter = b + m[..., None]
        m_t = jnp.maximum(inter, jnp.max(dmat, axis=-1))
        w = jnp.exp(dmat - m_t[..., None])
        s_inter = jnp.exp(inter - m_t)
        qk = jnp.einsum('bhtd,bhsd->bhts', qc, kc) * w
        num = s_inter[..., None] * jnp.einsum('bhtd,bhde->bhte', qc, C) + jnp.einsum('bhts,bhse->bhte', qk, vc)
        den = s_inter * jnp.einsum('bhtd,bhd->bht', qc, n) + jnp.sum(qk, axis=-1)
        h = num / jnp.maximum(jnp.abs(den), jnp.exp(-m_t))[..., None]
        bL = b[..., -1]
        g = bL[..., None] - b + ic
        m_new = jnp.maximum(bL + m, jnp.max(g, axis=-1))
        decay = jnp.exp(bL + m - m_new)
        wk = jnp.exp(g - m_new[..., None])[..., None] * kc
        C_new = decay[..., None, None] * C + jnp.einsum('bhsd,bhse->bhde', wk, vc)
        n_new = decay[..., None] * n + jnp.sum(wk, axis=-2)
        return (C_new, n_new, m_new), h

    carry0 = (C0.astype(jnp.float32), n0.astype(jnp.float32), m0.astype(jnp.float32))
    (C, n, m), h = lax.scan(step, carry0, xs)
    h = jnp.moveaxis(h, (0, 2), (1, 3)).reshape(B, T, H, Dh)
    return h, C, n, m


def mlstm_bidirectional(q, k, v, log_i, log_f, C0, n0, m0):
    rev = lambda a: jnp.flip(a, axis=1)
    h_f, Cf, nf, mf = mlstm_chunkwise(q, k, v, log_i[:, :, 0], log_f[:, :, 0], C0[:, 0], n0[:, 0], m0[:, 0])
    h_b, Cb, nb, mb = mlstm_chunkwise(rev(q), rev(k), rev(v), rev(log_i[:, :, 1]), rev(log_f[:, :, 1]),
                                      C0[:, 1], n0[:, 1], m0[:, 1])
    h = h_f + rev(h_b)
    return h, jnp.stack([Cf, Cb], axis=1), jnp.stack([nf, nb], axis=1), jnp.stack([mf, mb], axis=1)


def token_mixer(h, rope, ctx_ckv, ctx_krope, state0, w_in, gate_b, q_norm, kv_norm, w_uq, w_ukv,
                w_mla_o, head_norm, w_mlstm_o, w_out):
    B, T, _ = h.shape
    idx = np.cumsum(IN_SIZES)[:-1].tolist()
    mq, mk, mv, mo, mg, cq, ckv, krope, merge = jnp.split(h @ w_in, idx, axis=-1)

    ckv = rmsnorm(ckv, kv_norm)
    q = jnp.einsum('btr,rhd->bthd', rmsnorm(cq, q_norm), w_uq)
    q_nope, q_rope = q[..., :NOPE], q[..., NOPE:]
    if rope is not None:
        cos, sin = rope
        q_rope = apply_rope(q_rope, cos[:, None, :], sin[:, None, :])
        keys_ckv = jnp.concatenate([ckv, ctx_ckv.astype(ckv.dtype)], axis=1)
        keys_rope = jnp.concatenate([apply_rope(krope, cos, sin), ctx_krope.astype(krope.dtype)], axis=1)
    else:
        keys_ckv, keys_rope = ckv, krope
    S = keys_ckv.shape[1]
    kv = jnp.einsum('bsr,rhd->bshd', keys_ckv, w_ukv)
    k = jnp.concatenate([kv[..., :NOPE], jnp.broadcast_to(keys_rope[:, :, None, :], (B, S, H_A, ROPE_DIM))], axis=-1)
    attn = blocked_attention(jnp.concatenate([q_nope, q_rope], axis=-1), k, kv[..., NOPE:])
    y_attn = attn.reshape(B, T, H_A * V_DIM) @ w_mla_o

    g = mg.reshape(B, T, 2, 2, H_M).astype(jnp.float32) + gate_b.astype(jnp.float32)
    log_i, log_f = g[:, :, :, 0], jax.nn.log_sigmoid(g[:, :, :, 1])
    heads = lambda a: a.reshape(B, T, H_M, DH_M)
    hm, C, n, m = mlstm_bidirectional(heads(mq) * DH_M ** -0.5, heads(mk), heads(mv), log_i, log_f, *state0)
    hm = rmsnorm(hm, head_norm).astype(h.dtype).reshape(B, T, MLSTM_W)
    y_mlstm = (jax.nn.sigmoid(mo) * hm) @ w_mlstm_o

    g_a, g_b = jnp.split(jax.nn.sigmoid(merge), 2, axis=-1)
    out = (g_a * y_mlstm + g_b * y_attn) @ w_out
    return out, ckv, krope, C, n, m


def trunk_layer(x, mod, rope, ctx_ckv, ctx_krope, state0, pre1, post1, pre2, post2, w_mlp1, w_mlp2, mix_w):
    shift1, scale1, gate1, shift2, scale2, gate2 = jnp.split(mod, N_MOD, axis=-1)
    h = rmsnorm(x, pre1) * (1 + scale1) + shift1
    mix, ckv, krope, C, n, m = token_mixer(h, rope, ctx_ckv, ctx_krope, state0, *mix_w)
    x = x + gate1 * rmsnorm(mix, post1)
    h = rmsnorm(x, pre2) * (1 + scale2) + shift2
    ff = jnp.square(jax.nn.relu(h @ w_mlp1)) @ w_mlp2
    x = x + gate2 * rmsnorm(ff, post2)
    return x, ckv, krope, C, n, m


def setup_inputs(seed: int = 0) -> dict:
    key = jax.random.key(seed)
    ks = jax.random.split(key, 27)
    f32 = jnp.float32

    def nrm(i, shape, scale=1.0):
        return jax.random.normal(ks[i], shape, f32) * scale

    def gain(i, shape):
        return 1.0 + 0.05 * nrm(i, shape)

    L = DEPTH
    gate_base = jnp.array([0.0, 3.0], f32)[None, None, :, None]
    return {
        "x_prompt": nrm(0, (BATCH, SEQ, D_MODEL)),
        "x_sample": nrm(1, (DEC_BATCH, DEC_SEQ, D_MODEL)),
        "cache_mla_ckv": nrm(2, (DEC_BATCH, L, PAST_LEN, KV_LORA)),
        "cache_mla_krope": nrm(3, (DEC_BATCH, L, PAST_LEN, ROPE_DIM)),
        "state_mlstm_C": nrm(4, (DEC_BATCH, L, 2, H_M, DH_M, DH_M), 0.1),
        "state_mlstm_n": nrm(5, (DEC_BATCH, L, 2, H_M, DH_M), 0.1),
        "state_mlstm_m": nrm(6, (DEC_BATCH, L, 2, H_M)),
        "c": nrm(7, (DEC_BATCH, D_MODEL)),
        "c_ctx": nrm(8, (D_MODEL,)),
        "w_ada": nrm(9, (L, D_MODEL, N_MOD * D_MODEL), D_MODEL ** -0.5),
        "b_ada": nrm(10, (L, N_MOD * D_MODEL), 0.02),
        "norm_pre1": gain(11, (L, D_MODEL)),
        "norm_post1": gain(12, (L, D_MODEL)),
        "norm_pre2": gain(13, (L, D_MODEL)),
        "norm_post2": gain(14, (L, D_MODEL)),
        "w_in": nrm(15, (L, D_MODEL, IN_COLS), D_MODEL ** -0.5),
        "mlstm_gate_b": gate_base + 0.1 * nrm(16, (L, 2, 2, H_M)),
        "mla_q_norm": gain(17, (L, Q_LORA)),
        "mla_kv_norm": gain(18, (L, KV_LORA)),
        "w_uq": nrm(19, (L, Q_LORA, H_A, NOPE + ROPE_DIM), Q_LORA ** -0.5),
        "w_ukv": nrm(20, (L, KV_LORA, H_A, NOPE + V_DIM), KV_LORA ** -0.5),
        "w_mla_o": nrm(21, (L, H_A * V_DIM, D_MODEL), (H_A * V_DIM) ** -0.5),
        "mlstm_head_norm": gain(22, (L, H_M, DH_M)),
        "w_mlstm_o": nrm(23, (L, MLSTM_W, D_MODEL), MLSTM_W ** -0.5),
        "w_out": nrm(24, (L, D_MODEL, D_MODEL), D_MODEL ** -0.5),
        "w_mlp1": nrm(25, (L, D_MODEL, D_FF), D_MODEL ** -0.5),
        "w_mlp2": nrm(26, (L, D_FF, D_MODEL), D_FF ** -0.5),
    }


def reference(x_prompt, x_sample, cache_mla_ckv, cache_mla_krope, state_mlstm_C, state_mlstm_n, state_mlstm_m,
              c, c_ctx, w_ada, b_ada, norm_pre1, norm_post1, norm_pre2, norm_post2, w_in, mlstm_gate_b,
              mla_q_norm, mla_kv_norm, w_uq, w_ukv, w_mla_o, mlstm_head_norm, w_mlstm_o, w_out, w_mlp1, w_mlp2):
    f32 = jnp.float32
    Bp = x_prompt.shape[0]
    rope = axial_rope(x_sample.shape[1])
    zero_state = (jnp.zeros((Bp, 2, H_M, DH_M, DH_M), f32), jnp.zeros((Bp, 2, H_M, DH_M), f32),
                  jnp.full((Bp, 2, H_M), M_INIT, f32))
    xp, xs = x_prompt, x_sample
    new_ckv, new_krope, new_C, new_n, new_m = [], [], [], [], []
    for l in range(DEPTH):
        mix_w = (w_in[l], mlstm_gate_b[l], mla_q_norm[l], mla_kv_norm[l], w_uq[l], w_ukv[l], w_mla_o[l],
                 mlstm_head_norm[l], w_mlstm_o[l], w_out[l])
        norms = (norm_pre1[l], norm_post1[l], norm_pre2[l], norm_post2[l])
        mod_ctx = (jax.nn.silu(c_ctx) @ w_ada[l] + b_ada[l])[None, None, :]
        mod_lat = (jax.nn.silu(c) @ w_ada[l] + b_ada[l])[:, None, :]
        xp, ckv, krope, C, n, m = trunk_layer(xp, mod_ctx, None, None, None, zero_state, *norms,
                                              w_mlp1[l], w_mlp2[l], mix_w)
        new_ckv.append(ckv)
        new_krope.append(krope)
        new_C.append(C.astype(x_prompt.dtype))
        new_n.append(n.astype(x_prompt.dtype))
        new_m.append(m.astype(x_prompt.dtype))
        state_l = (state_mlstm_C[:, l], state_mlstm_n[:, l], state_mlstm_m[:, l])
        xs = trunk_layer(xs, mod_lat, rope, cache_mla_ckv[:, l], cache_mla_krope[:, l], state_l, *norms,
                         w_mlp1[l], w_mlp2[l], mix_w)[0]
    return (xp, xs, jnp.stack(new_ckv, axis=1), jnp.stack(new_krope, axis=1), jnp.stack(new_C, axis=1),
            jnp.stack(new_n, axis=1), jnp.stack(new_m, axis=1))
```

```cpp
#include <hip/hip_runtime.h>
#include <hip/hip_cooperative_groups.h>
#include <cstdio>
#include <cstdint>
#include <utility>
namespace cg = cooperative_groups;
__device__ __forceinline__ int tid_() { int t = threadIdx.x; asm volatile("" : "+v"(t)); return t; }
__device__ __forceinline__ int bid_() { int b = blockIdx.x; asm volatile("" : "+s"(b)); return b; }
template <class T> __device__ __forceinline__ T* gp_(T* q) { return (T*)(__attribute__((address_space(1))) T*)q; }
template <class T> __device__ __forceinline__ T* lp_(T* q) { return q; }
namespace pg8 {
#define PG8_LAS __attribute__((address_space(3)))
typedef unsigned short bf16_t;
typedef short bf16x8 __attribute__((ext_vector_type(8)));
typedef float f32x4 __attribute__((ext_vector_type(4)));
typedef unsigned u32x4 __attribute__((ext_vector_type(4)));
constexpr int BM = 256, BK = 64, HALF = 128, HTB = HALF * BK * 2  , STAGE_BYTES = 8 * HTB, NXCD = 8, WGM = 8;

__host__ __device__ __forceinline__ int lds_byte(int r, int c) { const int st = (r >> 4) * 2 + (c >> 5), rr = r & 15, cc = c & 31, ob = rr * 64 + cc * 2; return st * 1024 + (ob ^ (((ob >> 9) & 1) << 5)); }
__host__ __device__ __forceinline__ void stage_rc(int b, int& R, int& C) { const int st = b / 1024, sb = b % 1024, swz = sb ^ (((sb >> 9) & 1) << 5); R = (st >> 1) * 16 + swz / 64; C = (st & 1) * 32 + (swz % 64) / 2; }
__host__ __device__ __forceinline__ int perm32(int rho) { const int n = rho >> 4, i = rho & 15; return 8 * (i >> 2) + 4 * n + (i & 3); }

struct Unit { int pm, pn; };
struct Gemm { const bf16_t* A; const bf16_t* Bt; int M, N, K; };

struct StaticOrder {
    int nM, nN, nwg, G, c;
    __host__ __device__ void init(int M, int N, int G_, int c_) { nM = M / BM; nN = N / BM; nwg = nM * nN; G = G_; c = c_; }
    __host__ __device__ bool next(int i, Unit& u) const {
        const long L = (long)i * G + c; if (L >= nwg) return false;
        int wgid = (int)L; { const int q = nwg / NXCD, r = nwg % NXCD, xcd = wgid % NXCD, off = wgid / NXCD; wgid = (xcd < r ? xcd * (q + 1) : r * (q + 1) + (xcd - r) * q) + off; }
        const int nig = WGM * nN, gid = wgid / nig, fm = gid * WGM, gsz = (nM - fm) < WGM ? (nM - fm) : WGM;
        u.pm = fm + ((wgid % nig) % gsz); u.pn = (wgid % nig) / gsz; return true;
    }
    __device__ __forceinline__ void a_ready(const Unit&) const {}
    __device__ __forceinline__ void done(const Unit&) const {}
};
__device__ __forceinline__ unsigned cvt_pk_bf16(float lo, float hi) { unsigned r; asm volatile("v_cvt_pk_bf16_f32 %0, %1, %2" : "=v"(r) : "v"(lo), "v"(hi)); return r; }
template <class Epi, class Sched, bool ALIGN_EPI = false, bool SP2 = false>
__device__ __forceinline__ void gemm_phase(PG8_LAS unsigned char* lds, const Gemm g, const Sched& S, const Epi& E) {
    const int tid = tid_(), wid = __builtin_amdgcn_readfirstlane(tid >> 6), lane = tid & 63, wr = wid >> 2, wc = wid & 3, fr = lane & 15, fq = lane >> 4;
    const int K = g.K, nt = K / BK;
    unsigned voffA[2], voffB[2];
#pragma unroll
    for (int i = 0; i < 2; ++i) { int R, C; stage_rc(tid * 16 + i * 8192, R, C); const int Rb = Epi::PERM ? ((R & ~31) + perm32(R & 31)) : R;
        voffA[i] = (unsigned)(R * K + C) * 2u; voffB[i] = (unsigned)(Rb * K + C) * 2u; }
    const size_t kstep = (size_t)(BK * 2);
    const size_t hstep = (size_t)HALF * K * 2;
    const size_t tstep = 2 * hstep;
    const unsigned ldsw = (unsigned)wid * 1024u;
    const int aoff = lds_byte(wr * 64 + fr, fq * 8), boff = lds_byte(wc * 32 + fr, fq * 8);
#define PG8_SA(b, h) (((b) * 2 + (h)) * HTB)
#define PG8_SB(b, h) ((4 + (b) * 2 + (h)) * HTB)
#define PG8_STAGE(bufoff, gbase, voff) do { _Pragma("unroll") for (int _i = 0; _i < 2; ++_i) \
        __builtin_amdgcn_global_load_lds((const unsigned*)((const char*)(gbase) + (voff)[_i]), (PG8_LAS unsigned*)(lds + (bufoff) + ldsw + _i * 8192), 16, 0, 0); } while (0)
#define PG8_LDA(dst, b, h) do { _Pragma("unroll") for (int m = 0; m < 4; ++m) _Pragma("unroll") for (int k = 0; k < 2; ++k) dst[m][k] = *(const PG8_LAS bf16x8*)(lds + PG8_SA(b, h) + aoff + m * 2048 + k * 1024); } while (0)
#define PG8_LDB(dst, b, h) do { _Pragma("unroll") for (int n = 0; n < 2; ++n) _Pragma("unroll") for (int k = 0; k < 2; ++k) dst[n][k] = *(const PG8_LAS bf16x8*)(lds + PG8_SB(b, h) + boff + n * 2048 + k * 1024); } while (0)
#define PG8_MMA(ai, bj, At, Bt) do { __builtin_amdgcn_s_setprio(1); _Pragma("unroll") for (int m = 0; m < 4; ++m) _Pragma("unroll") for (int n = 0; n < 2; ++n) _Pragma("unroll") for (int k = 0; k < 2; ++k) \
        acc[ai][bj][m][n] = __builtin_amdgcn_mfma_f32_16x16x32_bf16(Bt[n][k], At[m][k], acc[ai][bj][m][n], 0, 0, 0); __builtin_amdgcn_s_setprio(0); } while (0)
#define PG8_WAIT_V(n) asm volatile("s_waitcnt vmcnt(" #n ")" ::: "memory")
#define PG8_WAIT_L(n) asm volatile("s_waitcnt lgkmcnt(" #n ")" ::: "memory")
#define PG8_BAR __builtin_amdgcn_s_barrier()
#define PG8_SCHED __builtin_amdgcn_sched_barrier(0)
    Unit cur, nxt; int ui = 0;
    if (!S.next(0, cur)) return;
    f32x4 acc[2][2][4][2];
#pragma unroll
    for (int a = 0; a < 2; ++a)
#pragma unroll
        for (int b = 0; b < 2; ++b)
#pragma unroll
            for (int m = 0; m < 4; ++m)
#pragma unroll
                for (int n = 0; n < 2; ++n) acc[a][b][m][n] = (f32x4){0.f, 0.f, 0.f, 0.f};
    bf16x8 At[4][2], B0[2][2], B1[2][2];
    const char* cA = (const char*)g.A + (size_t)cur.pm * tstep; const char* cB = (const char*)g.Bt + (size_t)cur.pn * tstep;
    S.a_ready(cur);
    if constexpr (SP2) {
        PG8_STAGE(PG8_SB(0, 0), cB, voffB); PG8_STAGE(PG8_SB(0, 1), cB + hstep, voffB); PG8_STAGE(PG8_SA(0, 0), cA, voffA); PG8_STAGE(PG8_SA(0, 1), cA + hstep, voffA);
        if (wr == 1) PG8_BAR;
        PG8_WAIT_V(2); PG8_BAR;
        PG8_STAGE(PG8_SB(1, 0), cB + kstep, voffB); PG8_STAGE(PG8_SA(1, 0), cA + kstep, voffA); PG8_STAGE(PG8_SB(1, 1), cB + hstep + kstep, voffB);
        PG8_WAIT_V(6); PG8_BAR;
    } else {
        PG8_STAGE(PG8_SB(0, 0), cB, voffB); PG8_STAGE(PG8_SA(0, 0), cA, voffA); PG8_STAGE(PG8_SB(0, 1), cB + hstep, voffB); PG8_STAGE(PG8_SA(0, 1), cA + hstep, voffA);
        if (wr == 1) PG8_BAR;
        PG8_WAIT_V(4); PG8_BAR;
        PG8_STAGE(PG8_SB(1, 0), cB + kstep, voffB); PG8_STAGE(PG8_SA(1, 0), cA + kstep, voffA); PG8_STAGE(PG8_SB(1, 1), cB + hstep + kstep, voffB);
        PG8_WAIT_V(6); PG8_BAR;
    }
    for (;;) {
        const bool has_next = S.next(ui + 1, nxt);
        const char* nA = has_next ? (const char*)g.A + (size_t)nxt.pm * tstep : cA; const char* nB = has_next ? (const char*)g.Bt + (size_t)nxt.pn * tstep : cB;
        for (int t = 0; t < nt; t += 2) {
            const bool last = (t == nt - 2);
            const char* a1 = cA + (size_t)(t + 1) * kstep;
            const char* a2 = last ? nA : cA + (size_t)(t + 2) * kstep; const char* b2 = last ? nB : cB + (size_t)(t + 2) * kstep;
            const char* a3 = a2 + kstep; const char* b3 = b2 + kstep;
            if (last && has_next) S.a_ready(nxt);
            if constexpr (SP2) {
            PG8_LDB(B0, 0, 0); PG8_LDB(B1, 0, 1); PG8_SCHED; PG8_LDA(At, 0, 0); PG8_STAGE(PG8_SA(1, 1), a1 + hstep, voffA);
            PG8_WAIT_V(8); PG8_WAIT_L(0); PG8_BAR; PG8_MMA(0, 0, At, B0); PG8_MMA(0, 1, At, B1); PG8_BAR; PG8_SCHED;
            PG8_LDA(At, 0, 1); PG8_STAGE(PG8_SB(0, 0), b2, voffB); PG8_STAGE(PG8_SB(0, 1), b2 + hstep, voffB); PG8_STAGE(PG8_SA(0, 0), a2, voffA);
            PG8_WAIT_V(8); PG8_WAIT_L(0); PG8_BAR; PG8_MMA(1, 0, At, B0); PG8_MMA(1, 1, At, B1); PG8_BAR; PG8_SCHED;
            PG8_LDB(B0, 1, 0); PG8_LDB(B1, 1, 1); PG8_SCHED; PG8_LDA(At, 1, 0); PG8_STAGE(PG8_SA(0, 1), a2 + hstep, voffA);
            PG8_WAIT_V(8); PG8_WAIT_L(0); PG8_BAR; PG8_MMA(0, 0, At, B0); PG8_MMA(0, 1, At, B1); PG8_BAR; PG8_SCHED;
            PG8_LDA(At, 1, 1); PG8_STAGE(PG8_SB(1, 0), b3, voffB); PG8_STAGE(PG8_SB(1, 1), b3 + hstep, voffB); PG8_STAGE(PG8_SA(1, 0), a3, voffA);
            PG8_WAIT_V(8); PG8_WAIT_L(0); PG8_BAR; PG8_MMA(1, 0, At, B0); PG8_MMA(1, 1, At, B1); PG8_BAR; PG8_SCHED;
            } else {
            PG8_LDB(B0, 0, 0); PG8_SCHED; PG8_LDA(At, 0, 0); PG8_STAGE(PG8_SA(1, 1), a1 + hstep, voffA);
            PG8_WAIT_L(8); PG8_BAR; PG8_WAIT_L(0); PG8_MMA(0, 0, At, B0); PG8_BAR; PG8_SCHED;
            PG8_LDB(B1, 0, 1); PG8_STAGE(PG8_SB(0, 0), b2, voffB);
            PG8_BAR; PG8_WAIT_L(0); PG8_MMA(0, 1, At, B1); PG8_BAR;
            PG8_LDA(At, 0, 1); PG8_STAGE(PG8_SA(0, 0), a2, voffA);
            PG8_BAR; PG8_WAIT_L(0); PG8_MMA(1, 0, At, B0); PG8_BAR; PG8_SCHED;
            PG8_STAGE(PG8_SB(0, 1), b2 + hstep, voffB);
            PG8_WAIT_V(6); PG8_BAR; PG8_MMA(1, 1, At, B1); PG8_BAR;
            PG8_LDB(B0, 1, 0); PG8_SCHED; PG8_LDA(At, 1, 0); PG8_STAGE(PG8_SA(0, 1), a2 + hstep, voffA);
            PG8_WAIT_L(8); PG8_BAR; PG8_WAIT_L(0); PG8_MMA(0, 0, At, B0); PG8_BAR; PG8_SCHED;
            PG8_LDB(B1, 1, 1); PG8_STAGE(PG8_SB(1, 0), b3, voffB);
            PG8_BAR; PG8_WAIT_L(0); PG8_MMA(0, 1, At, B1); PG8_BAR;
            PG8_LDA(At, 1, 1); PG8_STAGE(PG8_SA(1, 0), a3, voffA);
            PG8_BAR; PG8_WAIT_L(0); PG8_MMA(1, 0, At, B0); PG8_BAR; PG8_SCHED;
            PG8_STAGE(PG8_SB(1, 1), b3 + hstep, voffB);
            PG8_WAIT_V(6); PG8_BAR; PG8_MMA(1, 1, At, B1); PG8_BAR;
            }
        }
        if constexpr (ALIGN_EPI) { if (wr == 0) PG8_BAR; }
        if constexpr (!Epi::AFTER_DRAIN) { E(acc, cur, wr, wc, fr, fq); S.done(cur); }
        if (!has_next) break;
#pragma unroll
        for (int a = 0; a < 2; ++a)
#pragma unroll
            for (int b = 0; b < 2; ++b)
#pragma unroll
                for (int m = 0; m < 4; ++m)
#pragma unroll
                    for (int n = 0; n < 2; ++n) acc[a][b][m][n] = (f32x4){0.f, 0.f, 0.f, 0.f};
        cur = nxt; cA = nA; cB = nB; ++ui;
        if constexpr (ALIGN_EPI) { if (wr == 1) PG8_BAR; }
    }
    PG8_WAIT_V(0);
    if constexpr (!ALIGN_EPI) { if (wr == 0) PG8_BAR; }
    PG8_BAR;
    if constexpr (Epi::AFTER_DRAIN) { E.fused(acc, cur, wr, wc, fr, fq, lds, wid, lane); S.done(cur); }
#undef PG8_SA
#undef PG8_SB
#undef PG8_STAGE
#undef PG8_LDA
#undef PG8_LDB
#undef PG8_MMA
#undef PG8_WAIT_V
#undef PG8_WAIT_L
#undef PG8_BAR
#undef PG8_SCHED
}
}

typedef unsigned short bf16_t;
typedef short bf16x8 __attribute__((ext_vector_type(8)));
typedef short s16x4 __attribute__((ext_vector_type(4)));
typedef float f32x4 __attribute__((ext_vector_type(4)));
typedef float f32x16 __attribute__((ext_vector_type(16)));
typedef unsigned u32x4 __attribute__((ext_vector_type(4)));
typedef unsigned u32x2 __attribute__((ext_vector_type(2)));
#define LAS __attribute__((address_space(3)))
#define DI __device__ __forceinline__

constexpr int NT = 512;
constexpr int R = 24576, RC = 8192, RK = 26624;
constexpr int DM = 1024, NIN = 4864;
constexpr size_t MiB = 1u << 20;
constexpr size_t WS_MOD = 0;
constexpr size_t WS_ROPE = 128 * 1024;
constexpr size_t WS_SC = 256 * 1024;
constexpr size_t WS_MP = 384 * 1024;
constexpr size_t WS_ADACNT = 768 * 1024;
constexpr size_t WS_NST = 1 * MiB;
constexpr size_t WS_GATES = 6 * MiB;
constexpr size_t WS_KRRAW = 8 * MiB;
constexpr size_t WS_WIN = 11 * MiB;
constexpr size_t WS_W1 = WS_WIN + (size_t)NIN * 1024 * 2;
constexpr size_t WS_W2 = WS_W1 + 8 * MiB;
constexpr size_t WS_WOUT = WS_W2 + 8 * MiB;
constexpr size_t WS_WOA = WS_WOUT + 2 * MiB;
constexpr size_t WS_WOM = WS_WOA + 1 * MiB;
constexpr size_t WS_WUQ = WS_WOM + 1 * MiB;
constexpr size_t WS_WUK = WS_WUQ + 768 * 384 * 2;
constexpr size_t WS_WV = WS_WUK + 512 * 256 * 2;
static_assert(WS_WV + 512 * 256 * 2 <= 42 * MiB, "weights");
constexpr size_t WS_MQKV = 42 * MiB;
constexpr size_t WS_Q = 42 * MiB;
constexpr size_t WS_KN = 78 * MiB;
constexpr size_t WS_Z = 42 * MiB;
constexpr size_t WS_H2 = 208 * MiB;
constexpr size_t WS_P0 = 42 * MiB, WS_P1 = 58 * MiB;
constexpr size_t WS_F1 = 74 * MiB;
constexpr int RA_ROWS = 16384, RB_ROWS = 8192;
constexpr size_t WS_MO = 114 * MiB;
constexpr size_t WS_MG = 138 * MiB;
constexpr size_t WS_CQ = 234 * MiB;
constexpr size_t WS_KR = 252 * MiB;
constexpr size_t WS_END = 256 * MiB;
constexpr size_t DO_H1 = 0;
constexpr size_t DO_SLOT = 0;
constexpr size_t DO_VT = 0;
constexpr size_t DO_AO = 26 * MiB;
constexpr size_t DO_CKV = 48 * MiB;
constexpr size_t DO_KC = 60 * MiB;
constexpr size_t OUT_CKV = 25165824, OUT_KROPE = 27262976, OUT_C = 27525120, OUT_N = 31719424, OUT_M = 31752192;

struct Params {
    const float* in[27];
    float* out; unsigned char* ws;
    int ph_lo, ph_hi;
};

DI unsigned pk2(float lo, float hi) { unsigned r; asm volatile("v_cvt_pk_bf16_f32 %0, %1, %2" : "=v"(r) : "v"(lo), "v"(hi)); return r; }
DI float bflo(unsigned u) { return __uint_as_float(u << 16); }
DI float bfhi(unsigned u) { return __uint_as_float(u & 0xffff0000u); }
DI float bf1(bf16_t u) { return __uint_as_float(((unsigned)u) << 16); }
DI float sigmoidf_(float x) { return __builtin_amdgcn_rcpf(1.f + __expf(-x)); }
DI float wave_sum(float v) {
#pragma unroll
    for (int o = 1; o < 64; o <<= 1) v += __shfl_xor(v, o);
    return v;
}
DI float wave_max(float v) {
#pragma unroll
    for (int o = 1; o < 64; o <<= 1) v = fmaxf(v, __shfl_xor(v, o));
    return v;
}
DI int crow(int reg, int h) { return (reg & 3) + 8 * (reg >> 2) + 4 * h; }
DI s16x4 tr_read(const LAS char* p) { return __builtin_bit_cast(s16x4, __builtin_amdgcn_ds_read_tr16_b64_v4i16((LAS s16x4*)p)); }
DI bf16x8 cat4(s16x4 a, s16x4 b) { bf16x8 r; r[0] = a[0]; r[1] = a[1]; r[2] = a[2]; r[3] = a[3]; r[4] = b[0]; r[5] = b[1]; r[6] = b[2]; r[7] = b[3]; return r; }
#define MFMA32(a, b, c) __builtin_amdgcn_mfma_f32_32x32x16_bf16((a), (b), (c), 0, 0, 0)
DI bf16x8 pack8(const f32x16& x, int s) {
    u32x4 p; p[0] = pk2(x[8 * s], x[8 * s + 1]); p[1] = pk2(x[8 * s + 2], x[8 * s + 3]); p[2] = pk2(x[8 * s + 4], x[8 * s + 5]); p[3] = pk2(x[8 * s + 6], x[8 * s + 7]);
    return __builtin_bit_cast(bf16x8, p);
}

enum { EM_IN = 0, EM_Q, EM_BF16, EM_G1, EM_G2, EM_F32, EM_RELU2, EM_ADD };
struct EpiGen {
    static constexpr bool PERM = true, AFTER_DRAIN = false;
    int mode; int ldc; size_t hstride;
    void* out;
    unsigned char* ws; float* dout; const float* gate_b;
    DI void st8bf(bf16_t* p, f32x4 a, f32x4 b) const { u32x4 w; w.x = pk2(a[0], a[1]); w.y = pk2(a[2], a[3]); w.z = pk2(b[0], b[1]); w.w = pk2(b[2], b[3]); *(u32x4*)p = w; }
    template <int MODE> DI void one(int row, int col, int pn, f32x4 v0, f32x4 v1) const {
        switch (MODE) {
        case EM_IN: {
            if (pn < 6) {
                const float sc = pn < 2 ? 0.08838834764831845f : 1.f;
                st8bf((bf16_t*)(ws + WS_MQKV) + (size_t)row * 1536 + col, v0 * sc, v1 * sc);
            } else if (pn < 8) {
#pragma unroll
                for (int e = 0; e < 4; ++e) { v0[e] = sigmoidf_(v0[e]); v1[e] = sigmoidf_(v1[e]); }
                st8bf((bf16_t*)(ws + WS_MO) + (size_t)row * 512 + (col - 1536), v0, v1);
            } else if (pn < 11) {
                const int cl = col - 2048;
                if (cl < 384) st8bf((bf16_t*)(ws + WS_CQ) + (size_t)row * 384 + cl, v0, v1);
                else if (cl < 416) { float* d = (float*)(ws + WS_KRRAW) + (size_t)row * 32 + (cl - 384); *(f32x4*)d = v0; *(f32x4*)(d + 4) = v1; }
                else if (cl < 432) {
                    const int gi = cl - 416; f32x4 bi = *(const f32x4*)(gate_b + gi), bfv = *(const f32x4*)(gate_b + gi + 4);
                    f32x4 li = v0 + bi, x = v1 + bfv, lf;
#pragma unroll
                    for (int e = 0; e < 4; ++e) lf[e] = x[e] > 0.f ? -log1pf(__expf(-x[e])) : x[e] - log1pf(__expf(x[e]));
                    float* d = (float*)(ws + WS_GATES) + (size_t)row * 16 + gi; *(f32x4*)d = li; *(f32x4*)(d + 4) = lf;
                } else if (cl < 512) { }
                else st8bf((bf16_t*)((unsigned char*)dout + DO_CKV) + (size_t)row * 256 + (cl - 512), v0, v1);
            } else {
#pragma unroll
                for (int e = 0; e < 4; ++e) { v0[e] = sigmoidf_(v0[e]); v1[e] = sigmoidf_(v1[e]); }
                st8bf((bf16_t*)(ws + WS_MG) + (size_t)row * 2048 + (col - 2816), v0, v1);
            }
        } break;
        case EM_Q: {
            const float sc = 0.10206207261596577f * 1.4426950408889634f;
            const int d = col % 96;
            if (row >= RC && d >= 64) {
                const int t = (row - RC) & 4095, pi0 = (d - 64) >> 1;
                const int pos = pi0 < 8 ? (t >> 6) : (t & 63);
                const float* ct = (const float*)(ws + WS_ROPE) + pos * 8 + (pi0 & 7); const float* stb = ct + 512;
                const f32x4 c = *(const f32x4*)ct, s = *(const f32x4*)stb;
                f32x4 a, b;
                a[0] = v0[0] * c[0] - v0[1] * s[0]; a[1] = v0[0] * s[0] + v0[1] * c[0];
                a[2] = v0[2] * c[1] - v0[3] * s[1]; a[3] = v0[2] * s[1] + v0[3] * c[1];
                b[0] = v1[0] * c[2] - v1[1] * s[2]; b[1] = v1[0] * s[2] + v1[1] * c[2];
                b[2] = v1[2] * c[3] - v1[3] * s[3]; b[3] = v1[2] * s[3] + v1[3] * c[3];
                v0 = a; v1 = b;
            }
            st8bf((bf16_t*)out + (size_t)row * 768 + col, v0 * sc, v1 * sc);
        } break;
        case EM_BF16: st8bf((bf16_t*)out + (size_t)row * ldc + col, v0, v1); break;
        case EM_G1: {
            const u32x4 g = *(const u32x4*)((const bf16_t*)(ws + WS_MG) + (size_t)row * 2048 + col);
            f32x4 a, b; a[0] = v0[0] * bflo(g.x); a[1] = v0[1] * bfhi(g.x); a[2] = v0[2] * bflo(g.y); a[3] = v0[3] * bfhi(g.y);
            b[0] = v1[0] * bflo(g.z); b[1] = v1[1] * bfhi(g.z); b[2] = v1[2] * bflo(g.w); b[3] = v1[3] * bfhi(g.w);
            st8bf((bf16_t*)out + (size_t)row * 1024 + col, a, b);
        } break;
        case EM_G2: {
            const u32x4 g = *(const u32x4*)((const bf16_t*)(ws + WS_MG) + (size_t)row * 2048 + 1024 + col);
            const u32x4 z = *(const u32x4*)((const bf16_t*)out + (size_t)row * 1024 + col);
            f32x4 a, b; a[0] = bflo(z.x) + v0[0] * bflo(g.x); a[1] = bfhi(z.x) + v0[1] * bfhi(g.x); a[2] = bflo(z.y) + v0[2] * bflo(g.y); a[3] = bfhi(z.y) + v0[3] * bfhi(g.y);
            b[0] = bflo(z.z) + v1[0] * bflo(g.z); b[1] = bfhi(z.z) + v1[1] * bfhi(g.z); b[2] = bflo(z.w) + v1[2] * bflo(g.w); b[3] = bfhi(z.w) + v1[3] * bfhi(g.w);
            st8bf((bf16_t*)out + (size_t)row * 1024 + col, a, b);
        } break;
        case EM_F32: { float* d = (float*)out + (size_t)row * ldc + col; *(f32x4*)d = v0; *(f32x4*)(d + 4) = v1; } break;
        case EM_RELU2: {
#pragma unroll
            for (int e = 0; e < 4; ++e) { const float a = fmaxf(v0[e], 0.f), b = fmaxf(v1[e], 0.f); v0[e] = a * a; v1[e] = b * b; }
            st8bf((bf16_t*)out + (size_t)(col >> 11) * hstride + (size_t)row * 2048 + (col & 2047), v0, v1);
        } break;
        case EM_ADD: {
            bf16_t* d = (bf16_t*)out + (size_t)row * ldc + col; const u32x4 z = *(const u32x4*)d;
            f32x4 a, b; a[0] = bflo(z.x) + v0[0]; a[1] = bfhi(z.x) + v0[1]; a[2] = bflo(z.y) + v0[2]; a[3] = bfhi(z.y) + v0[3];
            b[0] = bflo(z.z) + v1[0]; b[1] = bfhi(z.z) + v1[1]; b[2] = bflo(z.w) + v1[2]; b[3] = bfhi(z.w) + v1[3];
            st8bf(d, a, b);
        } break;
        }
    }
    template <int MODE, int I> DI void step(const f32x4 (&acc)[2][2][4][2], const pg8::Unit& u, int wr, int wc, int fr, int fq) const {
        constexpr int ai = I >> 3, m = (I >> 1) & 3, bj = I & 1;
        one<MODE>(u.pm * 256 + ai * 128 + wr * 64 + m * 16 + fr, u.pn * 256 + bj * 128 + wc * 32 + 8 * fq, u.pn, acc[ai][bj][m][0], acc[ai][bj][m][1]);
    }
    template <int MODE, int... Is> DI void runseq(std::integer_sequence<int, Is...>, const f32x4 (&acc)[2][2][4][2], const pg8::Unit& u, int wr, int wc, int fr, int fq) const {
        (step<MODE, Is>(acc, u, wr, wc, fr, fq), ...);
    }
    template <int MODE> DI void run(const f32x4 (&acc)[2][2][4][2], const pg8::Unit& u, int wr, int wc, int fr, int fq) const {
        runseq<MODE>(std::make_integer_sequence<int, 16>{}, acc, u, wr, wc, fr, fq);
    }
    DI void operator()(const f32x4 (&acc)[2][2][4][2], const pg8::Unit& u, int wr, int wc, int fr, int fq) const {
        switch (mode) {
        case EM_IN: run<EM_IN>(acc, u, wr, wc, fr, fq); break;
        case EM_Q: run<EM_Q>(acc, u, wr, wc, fr, fq); break;
        case EM_BF16: run<EM_BF16>(acc, u, wr, wc, fr, fq); break;
        case EM_G1: run<EM_G1>(acc, u, wr, wc, fr, fq); break;
        case EM_G2: run<EM_G2>(acc, u, wr, wc, fr, fq); break;
        case EM_F32: run<EM_F32>(acc, u, wr, wc, fr, fq); break;
        case EM_ADD: run<EM_ADD>(acc, u, wr, wc, fr, fq); break;
        default: run<EM_RELU2>(acc, u, wr, wc, fr, fq); break;
        }
    }
};

DI int win_src(int n) {
    if (n < 2048) return n;
    if (n < 2432) return n + 16;
    if (n < 2464) return n - 2432 + 2704;
    if (n < 2480) return n - 2464 + 2048;
    if (n < 2560) return -1;
    if (n < 2816) return n - 2560 + 2448;
    return n - 2816 + 2736;
}
DI void transpose_item(const float* __restrict__ W, int K, int Nsrc, bf16_t* WT, int nblk, int mode, float* scr, int item, int lane) {
    const int kb = item / nblk, nb = item % nblk, k0 = 64 * kb, n0 = 32 * nb;
    const int nd = n0 + (lane & 31);
    int src = nd;
    if (mode == 1) src = win_src(nd); else if (mode == 2) src = (nd >> 6) * 128 + (nd & 63); else if (mode == 3) src = (nd >> 6) * 128 + 64 + (nd & 63);
#pragma unroll 8
    for (int i = 0; i < 32; ++i) { const int kk = 2 * i + (lane >> 5); scr[kk * 33 + (lane & 31)] = src >= 0 ? W[(size_t)(k0 + kk) * Nsrc + src] : 0.f; }
    asm volatile("s_waitcnt lgkmcnt(0)" ::: "memory"); asm volatile("" ::: "memory");
    const int c = lane & 7;
#pragma unroll
    for (int j = 0; j < 4; ++j) { const int n = (lane >> 3) + 8 * j; const float* s = scr + (8 * c) * 33 + n;
        u32x4 o; o.x = pk2(s[0 * 33], s[1 * 33]); o.y = pk2(s[2 * 33], s[3 * 33]); o.z = pk2(s[4 * 33], s[5 * 33]); o.w = pk2(s[6 * 33], s[7 * 33]);
        *(u32x4*)(WT + (size_t)(n0 + n) * K + k0 + 8 * c) = o; }
    asm volatile("s_waitcnt lgkmcnt(0)" ::: "memory"); asm volatile("" ::: "memory");
}
DI void phase_A(const Params& p, unsigned char* lds, const bool late) {
    const int tid = tid_(), lane = tid & 63, wave = tid >> 6;
    unsigned char* ws = lp_(p.ws);
    if (late) { }
    else if (bid_() < 192) {
        float* red = (float*)lds;
        float* sl = (float*)lds + 16 * 5 * 32;
        const float* wa = p.in[9]; const float* cl = p.in[7]; const float* cc = p.in[8];
        for (int e = tid; e < 5 * 1024; e += NT) { const float c = e < 1024 ? cc[e] : cl[e - 1024]; sl[e] = c * sigmoidf_(c); }
        __syncthreads();
        const int col = tid & 31, kg = tid >> 5, n0 = bid_() * 32;
        float acc[5] = {0.f, 0.f, 0.f, 0.f, 0.f};
        for (int k0 = kg; k0 < 1024; k0 += 16 * 8) {
            float w[8];
#pragma unroll
            for (int q = 0; q < 8; ++q) w[q] = wa[(size_t)(k0 + 16 * q) * 6144 + n0 + col];
#pragma unroll
            for (int q = 0; q < 8; ++q)
#pragma unroll
                for (int v = 0; v < 5; ++v) acc[v] += sl[v * 1024 + k0 + 16 * q] * w[q];
        }
#pragma unroll
        for (int v = 0; v < 5; ++v) red[(kg * 5 + v) * 32 + col] = acc[v];
        __syncthreads();
        if (tid < 160) { const int v = tid >> 5, c = tid & 31; float s = 0.f;
            for (int g = 0; g < 16; ++g) s += red[(g * 5 + v) * 32 + c];
            __hip_atomic_store((float*)(ws + WS_MOD) + v * 6144 + n0 + c, s + p.in[10][n0 + c], __ATOMIC_RELAXED, __HIP_MEMORY_SCOPE_AGENT); }
        asm volatile("s_waitcnt vmcnt(0)" ::: "memory");
        __syncthreads();
        if (tid == 0) __hip_atomic_fetch_add((unsigned*)(ws + WS_ADACNT), 1u, __ATOMIC_RELAXED, __HIP_MEMORY_SCOPE_AGENT);
    } else if (bid_() == 255) {
        const int pos = tid >> 3, j = tid & 7;
        double inv = 1.0; for (int i = 0; i < j; ++i) inv *= 0.31622776601683794;
        const double x = (double)pos * inv;
        const double kq = rint(x * 0.6366197723675814); const double r = x - kq * 1.5707963267948966, r2 = r * r;
        const double sn = r * (1.0 + r2 * (-1.0 / 6 + r2 * (1.0 / 120 + r2 * (-1.0 / 5040 + r2 * (1.0 / 362880 + r2 * (-1.0 / 39916800 + r2 * (1.0 / 6227020800.0)))))));
        const double cs = 1.0 + r2 * (-0.5 + r2 * (1.0 / 24 + r2 * (-1.0 / 720 + r2 * (1.0 / 40320 + r2 * (-1.0 / 3628800 + r2 * (1.0 / 479001600.0))))));
        const int q = ((int)kq) & 3;
        const double cv = q == 0 ? cs : (q == 1 ? -sn : (q == 2 ? -cs : sn));
        const double sv = q == 0 ? sn : (q == 1 ? cs : (q == 2 ? -sn : -cs));
        float* T = (float*)(ws + WS_ROPE); T[pos * 8 + j] = (float)cv; T[512 + pos * 8 + j] = (float)sv;
    }
    float* scr = (float*)lds + wave * (64 * 33);
    const int gw = bid_() * 8 + wave, NGW = gridDim.x * 8;
    constexpr int I0 = 16 * 152, I1 = 6 * 24, I2 = 4 * 16, I3 = 4 * 16, I4 = 8 * 32, I5 = 8 * 32, I6 = 16 * 32, I7 = 16 * 128, I8 = 64 * 32;
    constexpr int NITEMS = I0 + I1 + I2 + I3 + I4 + I5 + I6 + I7 + I8;
    for (int it = late ? I0 + gw : gw; it < (late ? NITEMS : I0); it += NGW) {
        int r = it;
        if (r < I0) { transpose_item(p.in[15], 1024, 4784, (bf16_t*)(ws + WS_WIN), 152, 1, scr, r, lane); continue; } r -= I0;
        if (r < I1) { transpose_item(p.in[19], 384, 768, (bf16_t*)(ws + WS_WUQ), 24, 0, scr, r, lane); continue; } r -= I1;
        if (r < I2) { transpose_item(p.in[20], 256, 1024, (bf16_t*)(ws + WS_WUK), 16, 2, scr, r, lane); continue; } r -= I2;
        if (r < I3) { transpose_item(p.in[20], 256, 1024, (bf16_t*)(ws + WS_WV), 16, 3, scr, r, lane); continue; } r -= I3;
        if (r < I4) { transpose_item(p.in[21], 512, 1024, (bf16_t*)(ws + WS_WOA), 32, 0, scr, r, lane); continue; } r -= I4;
        if (r < I5) { transpose_item(p.in[23], 512, 1024, (bf16_t*)(ws + WS_WOM), 32, 0, scr, r, lane); continue; } r -= I5;
        if (r < I6) { transpose_item(p.in[24], 1024, 1024, (bf16_t*)(ws + WS_WOUT), 32, 0, scr, r, lane); continue; } r -= I6;
        if (r < I7) { transpose_item(p.in[25], 1024, 4096, (bf16_t*)(ws + WS_W1), 128, 0, scr, r, lane); continue; } r -= I7;
        if (r < 1024) transpose_item(p.in[26], 2048, 1024, (bf16_t*)(ws + WS_W2), 32, 0, scr, r, lane);
        else transpose_item(p.in[26] + (size_t)2048 * 1024, 2048, 1024, (bf16_t*)(ws + WS_W2) + (size_t)1024 * 2048, 32, 0, scr, r - 1024, lane);
    }
}

DI const float* xrow_ptr(const Params& p, int row) { return row < RC ? p.in[0] + (size_t)row * DM : p.in[1] + (size_t)(row - RC) * DM; }
DI int row_group(int row) { return row < RC ? 0 : 1 + ((row - RC) >> 12); }
DI float ssq4(const f32x4& v) { return (v.x * v.x + v.y * v.y) + (v.z * v.z + v.w * v.w); }
DI void phase_B(const Params& p) {
    constexpr int NR = 4;
    {
        if (tid_() == 0) { unsigned* c = (unsigned*)(lp_(p.ws) + WS_ADACNT); while (__hip_atomic_load(c, __ATOMIC_RELAXED, __HIP_MEMORY_SCOPE_AGENT) < 192u) __builtin_amdgcn_s_sleep(2);
            __builtin_amdgcn_fence(__ATOMIC_ACQUIRE, "agent"); asm volatile("s_waitcnt vmcnt(0)" ::: "memory"); }
        __syncthreads();
    }
    const int lane = tid_() & 63, gw = bid_() * 8 + (tid_() >> 6), NGW = gridDim.x * 8;
    const float* mod = (const float*)(lp_(p.ws) + WS_MOD); const float* nw = p.in[11];
    bf16_t* H1 = (bf16_t*)((unsigned char*)p.out + DO_H1);
    for (int row0 = gw * NR; row0 < R; row0 += NGW * NR) {
        f32x4 v[NR][4]; float s[NR];
#pragma unroll
        for (int r = 0; r < NR; ++r) { const f32x4* xr = (const f32x4*)xrow_ptr(p, row0 + r) + lane;
#pragma unroll
            for (int j = 0; j < 4; ++j) v[r][j] = xr[64 * j]; }
#pragma unroll
        for (int r = 0; r < NR; ++r) { s[r] = 0.f;
#pragma unroll
            for (int j = 0; j < 4; ++j) s[r] += ssq4(v[r][j]);
            s[r] = rsqrtf(wave_sum(s[r]) * (1.f / DM) + 1e-6f); }
        const float* mv = mod + row_group(row0) * 6144;
#pragma unroll
        for (int j = 0; j < 4; ++j) { const int c = 4 * lane + 256 * j;
            const f32x4 w = *(const f32x4*)(nw + c), sh = *(const f32x4*)(mv + c), sc = *(const f32x4*)(mv + 1024 + c);
#pragma unroll
            for (int r = 0; r < NR; ++r) { const f32x4 h = v[r][j] * s[r] * w * (sc + 1.f) + sh;
                u32x2 o; o.x = pk2(h.x, h.y); o.y = pk2(h.z, h.w); *(u32x2*)(H1 + (size_t)(row0 + r) * DM + c) = o; } }
    }
}
DI void phase_I(const Params& p) {
    constexpr int NR = 4;
    const int lane = tid_() & 63, gw = bid_() * 8 + (tid_() >> 6), NGW = gridDim.x * 8;
    const float* mod = (const float*)(lp_(p.ws) + WS_MOD); const float* post1 = p.in[12]; const float* pre2 = p.in[13];
    const bf16_t* MIX = (const bf16_t*)(p.ws + WS_MG); bf16_t* H2 = (bf16_t*)(p.ws + WS_H2);
    for (int row0 = gw * NR; row0 < R; row0 += NGW * NR) {
        f32x4 x[NR][4], m[NR][4]; float rs[NR], rstd[NR];
#pragma unroll
        for (int r = 0; r < NR; ++r) { const f32x4* xr = (const f32x4*)xrow_ptr(p, row0 + r) + lane; const u32x2* mr = (const u32x2*)(MIX + (size_t)(row0 + r) * DM) + lane;
#pragma unroll
            for (int j = 0; j < 4; ++j) { x[r][j] = xr[64 * j]; const u32x2 mm = mr[64 * j]; m[r][j].x = bflo(mm.x); m[r][j].y = bfhi(mm.x); m[r][j].z = bflo(mm.y); m[r][j].w = bfhi(mm.y); } }
#pragma unroll
        for (int r = 0; r < NR; ++r) { float s = 0.f;
#pragma unroll
            for (int j = 0; j < 4; ++j) s += ssq4(m[r][j]);
            rs[r] = rsqrtf(wave_sum(s) * (1.f / DM) + 1e-6f); }
        const float* mv = mod + row_group(row0) * 6144;
#pragma unroll
        for (int r = 0; r < NR; ++r) rstd[r] = 0.f;
#pragma unroll
        for (int j = 0; j < 4; ++j) { const int c = 4 * lane + 256 * j;
            const f32x4 w = *(const f32x4*)(post1 + c), g = *(const f32x4*)(mv + 2048 + c);
#pragma unroll
            for (int r = 0; r < NR; ++r) { x[r][j] = x[r][j] + g * (m[r][j] * rs[r] * w);
                *(f32x4*)(p.out + (size_t)(row0 + r) * DM + c) = x[r][j]; rstd[r] += ssq4(x[r][j]); } }
#pragma unroll
        for (int r = 0; r < NR; ++r) rstd[r] = rsqrtf(wave_sum(rstd[r]) * (1.f / DM) + 1e-6f);
#pragma unroll
        for (int j = 0; j < 4; ++j) { const int c = 4 * lane + 256 * j;
            const f32x4 w = *(const f32x4*)(pre2 + c), sh = *(const f32x4*)(mv + 3072 + c), sc = *(const f32x4*)(mv + 4096 + c);
#pragma unroll
            for (int r = 0; r < NR; ++r) { const f32x4 h = x[r][j] * rstd[r] * w * (sc + 1.f) + sh;
                u32x2 o; o.x = pk2(h.x, h.y); o.y = pk2(h.z, h.w); *(u32x2*)(H2 + (size_t)(row0 + r) * DM + c) = o; } }
    }
}
DI void phase_L(const Params& p, int row_start, int nrows, const bf16_t* F0, const bf16_t* F1, bool dry = false) {
    constexpr int NR = 4;
    const int lane = tid_() & 63, gw = bid_() * 8 + (tid_() >> 6), NGW = gridDim.x * 8;
    const float* mod = (const float*)(lp_(p.ws) + WS_MOD); const float* post2 = p.in[14];
    for (int rl0 = gw * NR; rl0 < nrows; rl0 += NGW * NR) {
        f32x4 f[NR][4], y[NR][4]; float rs[NR];
#pragma unroll
        for (int r = 0; r < NR; ++r) { const u32x2* fr = (const u32x2*)(F0 + (size_t)(rl0 + r) * DM) + lane; const f32x4* yr = (const f32x4*)(p.out + (size_t)(row_start + rl0 + r) * DM) + lane;
#pragma unroll
            for (int j = 0; j < 4; ++j) { const u32x2 ff = fr[64 * j]; f[r][j].x = bflo(ff.x); f[r][j].y = bfhi(ff.x); f[r][j].z = bflo(ff.y); f[r][j].w = bfhi(ff.y); y[r][j] = yr[64 * j]; }
            if (F1) { const u32x2* gr = (const u32x2*)(F1 + (size_t)(rl0 + r) * DM) + lane;
#pragma unroll
                for (int j = 0; j < 4; ++j) { const u32x2 ff = gr[64 * j]; f[r][j].x += bflo(ff.x); f[r][j].y += bfhi(ff.x); f[r][j].z += bflo(ff.y); f[r][j].w += bfhi(ff.y); } } }
#pragma unroll
        for (int r = 0; r < NR; ++r) { float s = 0.f;
#pragma unroll
            for (int j = 0; j < 4; ++j) s += ssq4(f[r][j]);
            rs[r] = rsqrtf(wave_sum(s) * (1.f / DM) + 1e-6f); }
        const float* mv = mod + row_group(row_start + rl0) * 6144;
#pragma unroll
        for (int j = 0; j < 4; ++j) { const int c = 4 * lane + 256 * j;
            const f32x4 w = *(const f32x4*)(post2 + c), g = *(const f32x4*)(mv + 5120 + c);
#pragma unroll
            for (int r = 0; r < NR; ++r) if (!dry || rs[r] == 12345.678f) *(f32x4*)(p.out + (size_t)(row_start + rl0 + r) * DM + c) = y[r][j] + g * (f[r][j] * rs[r] * w); }
    }
}
DI int key_row(int row) { return row < RC ? row : RC + ((row - RC) >> 12) * 4608 + ((row - RC) & 4095); }
DI void phase_D(const Params& p) {
    constexpr int NR = 4;
    const int tid = tid_(), lane = tid & 63, gw = bid_() * 8 + (tid >> 6), NGW = gridDim.x * 8, gt = bid_() * NT + tid, NGT = gridDim.x * NT;
    unsigned char* ws = lp_(p.ws); unsigned char* dob = (unsigned char*)p.out;
    bf16_t* CQ = (bf16_t*)(ws + WS_CQ); const bf16_t* CKV = (const bf16_t*)(dob + DO_CKV); const float* KRR = (const float*)(ws + WS_KRRAW);
    bf16_t* KC = (bf16_t*)(dob + DO_KC); bf16_t* KR = (bf16_t*)(ws + WS_KR); const float* RT = (const float*)(ws + WS_ROPE);
    const float* qn = p.in[17]; const float* kvn = p.in[18];
    for (int row0 = gw * NR; row0 < R; row0 += NGW * NR) {
        unsigned u[NR][3]; u32x2 kv[NR];
#pragma unroll
        for (int r = 0; r < NR; ++r) { const unsigned* cq = (const unsigned*)(CQ + (size_t)(row0 + r) * 384);
#pragma unroll
            for (int j = 0; j < 3; ++j) u[r][j] = cq[lane + 64 * j];
            kv[r] = *(const u32x2*)(CKV + (size_t)(row0 + r) * 256 + 4 * lane); }
#pragma unroll
        for (int r = 0; r < NR; ++r) { const int row = row0 + r; float s = 0.f;
#pragma unroll
            for (int j = 0; j < 3; ++j) { const float a = bflo(u[r][j]), b = bfhi(u[r][j]); s += a * a + b * b; }
            const float rq = rsqrtf(wave_sum(s) * (1.f / 384) + 1e-6f);
            unsigned* cq = (unsigned*)(CQ + (size_t)row * 384);
#pragma unroll
            for (int j = 0; j < 3; ++j) { const int c = 2 * (lane + 64 * j); cq[lane + 64 * j] = pk2(bflo(u[r][j]) * rq * qn[c], bfhi(u[r][j]) * rq * qn[c + 1]); }
            f32x4 v; v.x = bflo(kv[r].x); v.y = bfhi(kv[r].x); v.z = bflo(kv[r].y); v.w = bfhi(kv[r].y);
            const float rk = rsqrtf(wave_sum(ssq4(v)) * (1.f / 256) + 1e-6f);
            v = v * rk * *(const f32x4*)(kvn + 4 * lane);
            u32x2 o; o.x = pk2(v.x, v.y); o.y = pk2(v.z, v.w); *(u32x2*)(KC + (size_t)key_row(row) * 256 + 4 * lane) = o;
            if (row < RC) *(f32x4*)(p.out + OUT_CKV + (size_t)row * 256 + 4 * lane) = v; }
    }
    for (int e = gt; e < R * 16; e += NGT) { const int row = e >> 4, pi = e & 15;
        const float x1 = KRR[(size_t)row * 32 + 2 * pi], x2 = KRR[(size_t)row * 32 + 2 * pi + 1]; float o1 = x1, o2 = x2;
        if (row < RC) { p.out[OUT_KROPE + (size_t)row * 32 + 2 * pi] = x1; p.out[OUT_KROPE + (size_t)row * 32 + 2 * pi + 1] = x2; }
        else { const int t = (row - RC) & 4095, pos = pi < 8 ? (t >> 6) : (t & 63); const float c = RT[pos * 8 + (pi & 7)], sn = RT[512 + pos * 8 + (pi & 7)];
            o1 = x1 * c - x2 * sn; o2 = x1 * sn + x2 * c; }
        *(unsigned*)(KR + (size_t)key_row(row) * 32 + 2 * pi) = pk2(o1, o2); }
    for (int e = gt; e < 2048 * 64; e += NGT) { const int j2 = e >> 6, c4 = e & 63, b = j2 >> 9, j = j2 & 511, kr = RC + b * 4608 + 4096 + j;
        const f32x4 v = *(const f32x4*)(p.in[2] + (size_t)j2 * 256 + 4 * c4);
        u32x2 o; o.x = pk2(v.x, v.y); o.y = pk2(v.z, v.w); *(u32x2*)(KC + (size_t)kr * 256 + 4 * c4) = o; }
    for (int e = gt; e < 2048 * 16; e += NGT) { const int j2 = e >> 4, pi = e & 15, b = j2 >> 9, j = j2 & 511, kr = RC + b * 4608 + 4096 + j;
        *(unsigned*)(KR + (size_t)kr * 32 + 2 * pi) = pk2(p.in[3][(size_t)j2 * 32 + 2 * pi], p.in[3][(size_t)j2 * 32 + 2 * pi + 1]); }
}

constexpr int KT_STR = 320;
constexpr int KR_STR = 272;
DI void scan_add2(float x0, float x1, float& b0, float& b1, int lane) {
    float s = x0 + x1;
#pragma unroll
    for (int o = 1; o < 64; o <<= 1) { const float t = __shfl_up(s, o); if (lane >= o) s += t; }
    b1 = s; b0 = s - x1;
}
DI void scan_max2(float x0, float x1, float& m0, float& m1, int lane) {
    float s = fmaxf(x0, x1);
#pragma unroll
    for (int o = 1; o < 64; o <<= 1) { const float t = __shfl_up(s, o); if (lane >= o) s = fmaxf(s, t); }
    m1 = s; const float prev = __shfl_up(s, 1); m0 = lane > 0 ? fmaxf(prev, x0) : x0;
}
DI int tr_off(int lane, int r0, int c0) { const int i = lane & 15; return (r0 + (i >> 2)) * KT_STR + (c0 + 4 * (i & 3)) * 2; }

DI void phase_M1(const Params& p, unsigned char* lds) {
    const int tid = tid_(), lane = tid & 63, wave = tid >> 6, hh = lane >> 5, g1 = (lane >> 4) & 1;
    unsigned char* ws = lp_(p.ws);
    const bf16_t* MQKV = (const bf16_t*)(ws + WS_MQKV); const float* GATES = (const float*)(ws + WS_GATES);
    bf16_t* SLOT = (bf16_t*)((unsigned char*)p.out + DO_SLOT); float* NST = (float*)(ws + WS_NST); float* SC = (float*)(ws + WS_SC);
    unsigned char* Kt = lds; unsigned char* Vt = lds + 128 * KT_STR; float* wbuf = (float*)(lds + 2 * 128 * KT_STR);
    const LAS char* Kt3 = (const LAS char*)Kt; const LAS char* Vt3 = (const LAS char*)Vt;
#define M1_DECODE(u_, slot_, rowbase_, h_, d_) do { \
        if ((u_) < 512) { const int c = (u_) >> 1, k = (u_) & 1; d_ = c & 1; h_ = (c >> 1) & 3; const int s = c >> 3; rowbase_ = s * 256 + (d_ ? 1 - k : k) * 128; slot_ = 2 * c + k; } \
        else { const int v = (u_) - 512, lc = v / 31, k = v % 31; d_ = lc & 1; h_ = (lc >> 1) & 3; const int b = lc >> 3; rowbase_ = RC + b * 4096 + (d_ ? 31 - k : k) * 128; slot_ = 512 + 32 * lc + k + 1; } } while (0)
#define M1_LOAD(rowbase_, h_, d_) do { \
        _Pragma("unroll") for (int i = 0; i < 4; ++i) { const int id = tid + NT * i, row = id >> 4, ch = id & 15; \
            const bf16_t* src = MQKV + (size_t)((rowbase_) + row) * 1536 + (h_) * 128 + ch * 8; rk[i] = *(const u32x4*)(src + 512); rv[i] = *(const u32x4*)(src + 1024); } \
        if (wave == 0) { const int p0 = 2 * lane, p1 = p0 + 1, t0 = (d_) ? 127 - p0 : p0, t1 = (d_) ? 127 - p1 : p1; \
            gf0 = GATES[(size_t)((rowbase_) + t0) * 16 + (d_) * 8 + 4 + (h_)]; gf1 = GATES[(size_t)((rowbase_) + t1) * 16 + (d_) * 8 + 4 + (h_)]; \
            gi0 = GATES[(size_t)((rowbase_) + t0) * 16 + (d_) * 8 + (h_)]; gi1 = GATES[(size_t)((rowbase_) + t1) * 16 + (d_) * 8 + (h_)]; } } while (0)
    u32x4 rk[4], rv[4]; float gf0 = 0.f, gf1 = 0.f, gi0 = 0.f, gi1 = 0.f;
    int slot = 0, rowbase = 0, h = 0, d = 0;
    if (bid_() < 1504) { M1_DECODE(bid_(), slot, rowbase, h, d); M1_LOAD(rowbase, h, d); }
    for (int u = bid_(); u < 1504; u += gridDim.x) {
        if (wave == 0) {
            const int p0 = 2 * lane, p1 = p0 + 1, t0 = d ? 127 - p0 : p0, t1 = d ? 127 - p1 : p1;
            float b0, b1; scan_add2(gf0, gf1, b0, b1, lane);
            const float bL = __shfl(b1, 63);
            const float ga = bL - b0 + gi0, gb = bL - b1 + gi1, ml = wave_max(fmaxf(ga, gb));
            wbuf[t0] = __expf(ga - ml); wbuf[t1] = __expf(gb - ml);
            if (lane == 0) { SC[slot * 2] = bL; SC[slot * 2 + 1] = ml; }
        }
        __syncthreads();
#pragma unroll
        for (int i = 0; i < 4; ++i) { const int id = tid + NT * i, row = id >> 4, ch = id & 15;
            const u32x4 kv = rk[i]; const float w = wbuf[row];
            u32x4 ko; ko.x = pk2(bflo(kv.x) * w, bfhi(kv.x) * w); ko.y = pk2(bflo(kv.y) * w, bfhi(kv.y) * w); ko.z = pk2(bflo(kv.z) * w, bfhi(kv.z) * w); ko.w = pk2(bflo(kv.w) * w, bfhi(kv.w) * w);
            *(u32x4*)(Kt + row * KT_STR + ch * 16) = ko; *(u32x4*)(Vt + row * KT_STR + ch * 16) = rv[i]; }
        __syncthreads();
        const int cslot = slot;
        { const int un = u + gridDim.x; if (un < 1504) { M1_DECODE(un, slot, rowbase, h, d); M1_LOAD(rowbase, h, d); } }
        const int dvb = wave >> 1, dk0 = 2 * (wave & 1);
        f32x16 acc[2], accn[2];
#pragma unroll
        for (int e = 0; e < 16; ++e) { acc[0][e] = 0.f; acc[1][e] = 0.f; accn[0][e] = 0.f; accn[1][e] = 0.f; }
        bf16x8 ones;
#pragma unroll
        for (int e = 0; e < 8; ++e) ones[e] = (short)0x3f80;
#pragma unroll
        for (int ks = 0; ks < 8; ++ks) {
            const int r0 = 16 * ks + 8 * hh;
            const bf16x8 a = cat4(tr_read(Vt3 + tr_off(lane, r0, dvb * 32 + 16 * g1)), tr_read(Vt3 + tr_off(lane, r0 + 4, dvb * 32 + 16 * g1)));
#pragma unroll
            for (int j = 0; j < 2; ++j) {
                const bf16x8 b = cat4(tr_read(Kt3 + tr_off(lane, r0, (dk0 + j) * 32 + 16 * g1)), tr_read(Kt3 + tr_off(lane, r0 + 4, (dk0 + j) * 32 + 16 * g1)));
                acc[j] = MFMA32(a, b, acc[j]);
                if (dvb == 0) accn[j] = MFMA32(ones, b, accn[j]);
            }
        }
        bf16_t* so = SLOT + (size_t)cslot * 16384;
#pragma unroll
        for (int j = 0; j < 2; ++j)
#pragma unroll
            for (int e = 0; e < 16; ++e) so[(dvb * 32 + crow(e, hh)) * 128 + (dk0 + j) * 32 + (lane & 31)] = (bf16_t)(pk2(acc[j][e], 0.f) & 0xffffu);
        if (dvb == 0 && hh == 0) { NST[(size_t)cslot * 128 + dk0 * 32 + lane] = accn[0][0]; NST[(size_t)cslot * 128 + (dk0 + 1) * 32 + lane] = accn[1][0]; }
        __syncthreads();
    }
}

DI void phase_M2(const Params& p, unsigned char* lds) {
    const int gt = bid_() * NT + tid_();
    unsigned char* ws = lp_(p.ws);
    bf16_t* SLOT = (bf16_t*)((unsigned char*)p.out + DO_SLOT); float* NST = (float*)(ws + WS_NST); const float* SC = (const float*)(ws + WS_SC); float* MP = (float*)(ws + WS_MP);
    if (gt < 65536) {
        const int lc = gt >> 11, v = gt & 2047, dv = v >> 4, dko = v & 15, d = lc & 1, h = (lc >> 1) & 3, b = lc >> 3;
        const float* C0 = p.in[4] + (size_t)((b * 2 + d) * 4 + h) * 16384;
        float C[8];
#pragma unroll
        for (int j = 0; j < 8; ++j) C[j] = C0[(dko * 8 + j) * 128 + dv];
        float m = p.in[6][(b * 2 + d) * 4 + h];
        const int s0 = 512 + 32 * lc;
        { u32x4 o; o.x = pk2(C[0], C[1]); o.y = pk2(C[2], C[3]); o.z = pk2(C[4], C[5]); o.w = pk2(C[6], C[7]); *(u32x4*)(SLOT + (size_t)s0 * 16384 + v * 8) = o; }
        float nv[8];
        const bool isn = v < 16;
        if (isn) {
#pragma unroll
            for (int j = 0; j < 8; ++j) { nv[j] = p.in[5][((b * 2 + d) * 4 + h) * 128 + v * 8 + j]; NST[(size_t)s0 * 128 + v * 8 + j] = nv[j]; }
        }
        if (v == 0) MP[s0] = m;
        for (int k0 = 0; k0 < 31; k0 += 4) {
            u32x4 uu[4]; float bLs[4], mls[4]; float nu[4][8];
#pragma unroll
            for (int q = 0; q < 4; ++q) if (k0 + q < 31) { const int sl = s0 + k0 + q + 1;
                uu[q] = *(const u32x4*)(SLOT + (size_t)sl * 16384 + v * 8); bLs[q] = SC[sl * 2]; mls[q] = SC[sl * 2 + 1];
                if (isn) {
#pragma unroll
                    for (int jj = 0; jj < 8; ++jj) nu[q][jj] = NST[(size_t)sl * 128 + v * 8 + jj]; } }
#pragma unroll
            for (int q = 0; q < 4; ++q) if (k0 + q < 31) { const int sl = s0 + k0 + q + 1;
                const float bL = bLs[q], ml = mls[q];
                const float mn = fmaxf(bL + m, ml), dec = __expf(bL + m - mn), su = __expf(ml - mn);
                C[0] = dec * C[0] + su * bflo(uu[q].x); C[1] = dec * C[1] + su * bfhi(uu[q].x); C[2] = dec * C[2] + su * bflo(uu[q].y); C[3] = dec * C[3] + su * bfhi(uu[q].y);
                C[4] = dec * C[4] + su * bflo(uu[q].z); C[5] = dec * C[5] + su * bfhi(uu[q].z); C[6] = dec * C[6] + su * bflo(uu[q].w); C[7] = dec * C[7] + su * bfhi(uu[q].w);
                u32x4 o; o.x = pk2(C[0], C[1]); o.y = pk2(C[2], C[3]); o.z = pk2(C[4], C[5]); o.w = pk2(C[6], C[7]); *(u32x4*)(SLOT + (size_t)sl * 16384 + v * 8) = o;
                if (isn) {
#pragma unroll
                    for (int jj = 0; jj < 8; ++jj) { nv[jj] = dec * nv[jj] + su * nu[q][jj]; NST[(size_t)sl * 128 + v * 8 + jj] = nv[jj]; } }
                if (v == 0) MP[sl] = mn;
                m = mn; }
        }
    }
    if (bid_() < 128) {
        const int tid = tid_();
        float* T = (float*)lds;
        for (int c = bid_(); c < 256; c += 128) {
            const int d = c & 1, h = (c >> 1) & 3, s = c >> 3;
            const float bL1 = SC[(2 * c + 1) * 2], ml1 = SC[(2 * c + 1) * 2 + 1], ml0 = SC[(2 * c) * 2 + 1];
            const float m1 = ml0;
            const float m2 = fmaxf(bL1 + m1, ml1), dec = __expf(bL1 + m1 - m2), su = __expf(ml1 - m2);
            u32x4 u0[4], u1[4];
#pragma unroll
            for (int q = 0; q < 4; ++q) { const int v = tid + NT * q;
                u0[q] = *(const u32x4*)(SLOT + (size_t)(2 * c) * 16384 + v * 8); u1[q] = *(const u32x4*)(SLOT + (size_t)(2 * c + 1) * 16384 + v * 8); }
#pragma unroll
            for (int q = 0; q < 4; ++q) { const int v = tid + NT * q, dv = v >> 4, dk0 = (v & 15) * 8;
                T[(dk0 + 0) * 129 + dv] = dec * bflo(u0[q].x) + su * bflo(u1[q].x); T[(dk0 + 1) * 129 + dv] = dec * bfhi(u0[q].x) + su * bfhi(u1[q].x);
                T[(dk0 + 2) * 129 + dv] = dec * bflo(u0[q].y) + su * bflo(u1[q].y); T[(dk0 + 3) * 129 + dv] = dec * bfhi(u0[q].y) + su * bfhi(u1[q].y);
                T[(dk0 + 4) * 129 + dv] = dec * bflo(u0[q].z) + su * bflo(u1[q].z); T[(dk0 + 5) * 129 + dv] = dec * bfhi(u0[q].z) + su * bfhi(u1[q].z);
                T[(dk0 + 6) * 129 + dv] = dec * bflo(u0[q].w) + su * bflo(u1[q].w); T[(dk0 + 7) * 129 + dv] = dec * bfhi(u0[q].w) + su * bfhi(u1[q].w); }
            __syncthreads();
            float* oc = p.out + OUT_C + (size_t)((s * 2 + d) * 4 + h) * 16384;
#pragma unroll
            for (int q = 0; q < 8; ++q) { const int e = tid + NT * q, dk = e >> 5, dv4 = (e & 31) * 4;
                f32x4 o; o.x = T[dk * 129 + dv4]; o.y = T[dk * 129 + dv4 + 1]; o.z = T[dk * 129 + dv4 + 2]; o.w = T[dk * 129 + dv4 + 3];
                *(f32x4*)(oc + dk * 128 + dv4) = o; }
            if (tid < 128) {
                p.out[OUT_N + ((s * 2 + d) * 4 + h) * 128 + tid] = dec * NST[(size_t)(2 * c) * 128 + tid] + su * NST[(size_t)(2 * c + 1) * 128 + tid];
                if (tid == 0) { p.out[OUT_M + (s * 2 + d) * 4 + h] = m2; MP[2 * c] = m1; }
            }
            __syncthreads();
        }
    }
}

DI void phase_M3(const Params& p, unsigned char* lds, bool dry, const int u_first, const int u_end, const int u_step) {
    const int tid = tid_(), lane = tid & 63, wave = tid >> 6, hh = lane >> 5, g1 = (lane >> 4) & 1, l31 = lane & 31;
    unsigned char* ws = lp_(p.ws);
    const bf16_t* MQKV = (const bf16_t*)(ws + WS_MQKV); const float* GATES = (const float*)(ws + WS_GATES);
    const bf16_t* SLOT = (const bf16_t*)((unsigned char*)p.out + DO_SLOT); const float* NST = (const float*)(ws + WS_NST); const float* MP = (const float*)(ws + WS_MP);
    bf16_t* MO = (bf16_t*)(ws + WS_MO); const float* hn = p.in[22]; const float* SCm = (const float*)(ws + WS_SC);
    unsigned char* Kt = lds; unsigned char* Vt = lds + 128 * KR_STR;
    float* X = (float*)lds;
    float* ga = (float*)(lds + 128 * KR_STR + 128 * KT_STR);
    float* gc = ga + 256; float* gb = gc + 256; float* gn = gb + 256;
    const LAS char* Kt3 = (const LAS char*)Kt; const LAS char* Vt3 = (const LAS char*)Vt;
#define M3_DECODE(u_) do { \
        if ((u_) < 256) { lat = false; oc = (u_) & 1; h = ((u_) >> 1) & 3; const int s_ = (u_) >> 3; nc = 2; rowbase = s_ * 256 + oc * 128; cbase = (s_ * 4 + h) * 2; } \
        else { lat = true; const int v_ = (u_) - 256; oc = v_ & 31; h = (v_ >> 5) & 3; const int b_ = v_ >> 7; nc = 32; rowbase = RC + b_ * 4096 + oc * 128; cbase = (b_ * 4 + h) * 2; } \
        { const int k0_ = oc, k1_ = nc - 1 - oc; sl0 = lat ? 512 + 32 * cbase + k0_ : (k0_ == 1 ? 2 * cbase : -1); sl1 = lat ? 512 + 32 * (cbase + 1) + k1_ : (k1_ == 1 ? 2 * (cbase + 1) : -1); } } while (0)
#define M3_LOAD() do { \
        _Pragma("unroll") for (int i = 0; i < 4; ++i) { const int id = tid + NT * i, row = id >> 4, ch = id & 15; \
            const bf16_t* src = MQKV + (size_t)(rowbase + row) * 1536 + h * 128 + ch * 8; rk[i] = *(const u32x4*)(src + 512); rv[i] = *(const u32x4*)(src + 1024); } \
        if (wave < 2) { const int d_ = wave, sl_ = d_ ? sl1 : sl0; \
            const int p0 = 2 * lane, p1 = p0 + 1, t0 = d_ ? 127 - p0 : p0, t1 = d_ ? 127 - p1 : p1; \
            gf0 = GATES[(size_t)(rowbase + t0) * 16 + d_ * 8 + 4 + h]; gf1 = GATES[(size_t)(rowbase + t1) * 16 + d_ * 8 + 4 + h]; \
            gi0 = GATES[(size_t)(rowbase + t0) * 16 + d_ * 8 + h]; gi1 = GATES[(size_t)(rowbase + t1) * 16 + d_ * 8 + h]; \
            gmp = sl_ >= 0 ? (lat ? MP[sl_] : SCm[sl_ * 2 + 1]) : -1e30f; gn0 = sl_ >= 0 ? NST[(size_t)sl_ * 128 + lane] : 0.f; gn1 = sl_ >= 0 ? NST[(size_t)sl_ * 128 + 64 + lane] : 0.f; } } while (0)
    int rowbase = 0, h = 0, oc = 0, nc = 2, cbase = 0, sl0 = -1, sl1 = -1; bool lat = false;
    u32x4 rk[4], rv[4]; float gf0 = 0.f, gf1 = 0.f, gi0 = 0.f, gi1 = 0.f, gmp = 0.f, gn0 = 0.f, gn1 = 0.f;
    if (u_first >= 0 && u_first < u_end) { M3_DECODE(u_first); M3_LOAD(); }
    for (int u = u_first; u >= 0 && u < u_end; u += u_step) {
        if (wave < 2) {
            const int d = wave;
            const int p0 = 2 * lane, p1 = p0 + 1, t0 = d ? 127 - p0 : p0, t1 = d ? 127 - p1 : p1;
            float b0, b1; scan_add2(gf0, gf1, b0, b1, lane);
            const float a0 = gi0 - b0, a1 = gi1 - b1; float m0, m1; scan_max2(a0, a1, m0, m1, lane);
            ga[d * 128 + t0] = a0; ga[d * 128 + t1] = a1; gc[d * 128 + t0] = fmaxf(gmp, m0); gc[d * 128 + t1] = fmaxf(gmp, m1); gb[d * 128 + t0] = b0; gb[d * 128 + t1] = b1;
            gn[d * 128 + lane] = gn0; gn[d * 128 + 64 + lane] = gn1;
        }
#pragma unroll
        for (int i = 0; i < 4; ++i) { const int id = tid + NT * i, row = id >> 4, ch = id & 15;
            *(u32x4*)(Kt + row * KR_STR + ch * 16) = rk[i]; *(u32x4*)(Vt + row * KT_STR + ch * 16) = rv[i]; }
        __syncthreads();
        const int c_rowbase = rowbase, c_h = h;
        const int d = wave >> 2, tb = wave & 3, t = tb * 32 + l31, sl = d ? sl1 : sl0;
        const float mprev = sl >= 0 ? (u < 256 ? SCm[sl * 2 + 1] : MP[sl]) : -1e30f;
        const bf16_t* qrowp = MQKV + (size_t)(c_rowbase + t) * 1536 + c_h * 128 + 8 * hh;
        const float c_t = gc[d * 128 + t], b_t = gb[d * 128 + t];
        const float si = sl >= 0 ? __expf(mprev - c_t) : 0.f;
        float qn = 0.f;
        if (sl >= 0) {
#pragma unroll
            for (int ks = 0; ks < 8; ++ks) { const bf16x8 q = *(const bf16x8*)(qrowp + 16 * ks);
#pragma unroll
                for (int j = 0; j < 8; ++j) qn += bf1((bf16_t)q[j]) * gn[d * 128 + 16 * ks + 8 * hh + j]; }
        }
        qn += __shfl_xor(qn, 32);
        f32x16 H[4];
#pragma unroll
        for (int i = 0; i < 4; ++i)
#pragma unroll
            for (int e = 0; e < 16; ++e) H[i][e] = 0.f;
        float denp = 0.f;
        const int sb_lo = d ? tb : 0, sb_hi = d ? 3 : tb;
#pragma unroll 1
        for (int sb = sb_lo; sb <= sb_hi; ++sb) {
            f32x16 S;
#pragma unroll
            for (int e = 0; e < 16; ++e) S[e] = 0.f;
            const bf16_t* qp = qrowp; asm volatile("" : "+v"(qp));
#pragma unroll
            for (int ks = 0; ks < 8; ++ks) { const bf16x8 a = *(const LAS bf16x8*)(Kt3 + (sb * 32 + l31) * KR_STR + (16 * ks + 8 * hh) * 2); S = MFMA32(a, *(const bf16x8*)(qp + 16 * ks), S); }
#pragma unroll
            for (int e = 0; e < 16; ++e) { const int st = sb * 32 + crow(e, hh); const bool ok = d ? (st >= t) : (st <= t);
                const float w = ok ? __expf(ga[d * 128 + st] - c_t) : 0.f; const float pv = S[e] * w; denp += pv; S[e] = pv; }
            const bf16x8 pb0 = pack8(S, 0), pb1 = pack8(S, 1);
#pragma unroll
            for (int dvb = 0; dvb < 4; ++dvb) {
                const int r0 = sb * 32 + 4 * hh, c0 = dvb * 32 + 16 * g1;
                const bf16x8 a0 = cat4(tr_read(Vt3 + tr_off(lane, r0, c0)), tr_read(Vt3 + tr_off(lane, r0 + 8, c0)));
                const bf16x8 a1 = cat4(tr_read(Vt3 + tr_off(lane, r0 + 16, c0)), tr_read(Vt3 + tr_off(lane, r0 + 24, c0)));
                H[dvb] = MFMA32(a0, pb0, H[dvb]); H[dvb] = MFMA32(a1, pb1, H[dvb]);
            }
        }
        if (sl >= 0) {
            const bf16_t* ct = SLOT + (size_t)sl * 16384;
            const bf16_t* qp2 = qrowp; asm volatile("" : "+v"(qp2));
#pragma unroll
            for (int ks = 0; ks < 8; ++ks) { u32x4 q = *(const u32x4*)(qp2 + 16 * ks);
                q.x = pk2(bflo(q.x) * si, bfhi(q.x) * si); q.y = pk2(bflo(q.y) * si, bfhi(q.y) * si); q.z = pk2(bflo(q.z) * si, bfhi(q.z) * si); q.w = pk2(bflo(q.w) * si, bfhi(q.w) * si);
                const bf16x8 qs = __builtin_bit_cast(bf16x8, q);
#pragma unroll
                for (int dvb = 0; dvb < 4; ++dvb) { const bf16x8 a = *(const bf16x8*)(ct + (dvb * 32 + l31) * 128 + 16 * ks + 8 * hh); H[dvb] = MFMA32(a, qs, H[dvb]); }
            }
        }
        const float den = si * qn + (denp + __shfl_xor(denp, 32));
        const float inv = 1.f / fmaxf(fabsf(den), __expf(-(c_t + b_t)));
#pragma unroll
        for (int i = 0; i < 4; ++i)
#pragma unroll
            for (int e = 0; e < 16; ++e) H[i][e] *= inv;
        __syncthreads();
        { const int un = u + u_step; if (un < u_end) { M3_DECODE(un); M3_LOAD(); } }
        if (d == 1) {
#pragma unroll
            for (int dvb = 0; dvb < 4; ++dvb)
#pragma unroll
                for (int g = 0; g < 4; ++g) { f32x4 v; v.x = H[dvb][4 * g]; v.y = H[dvb][4 * g + 1]; v.z = H[dvb][4 * g + 2]; v.w = H[dvb][4 * g + 3]; *(f32x4*)(X + t * 132 + dvb * 32 + 8 * g + 4 * hh) = v; }
        }
        __syncthreads();
        if (d == 0) {
            float ss = 0.f;
#pragma unroll
            for (int dvb = 0; dvb < 4; ++dvb)
#pragma unroll
                for (int g = 0; g < 4; ++g) { const f32x4 v = *(const f32x4*)(X + t * 132 + dvb * 32 + 8 * g + 4 * hh);
                    H[dvb][4 * g] += v.x; H[dvb][4 * g + 1] += v.y; H[dvb][4 * g + 2] += v.z; H[dvb][4 * g + 3] += v.w;
                    ss += (H[dvb][4 * g] * H[dvb][4 * g] + H[dvb][4 * g + 1] * H[dvb][4 * g + 1]) + (H[dvb][4 * g + 2] * H[dvb][4 * g + 2] + H[dvb][4 * g + 3] * H[dvb][4 * g + 3]); }
            ss += __shfl_xor(ss, 32);
            const float rstd = rsqrtf(ss * (1.f / 128) + 1e-6f);
#pragma unroll
            for (int dvb = 0; dvb < 4; ++dvb)
#pragma unroll
                for (int g = 0; g < 4; ++g) { const int dv = dvb * 32 + 8 * g + 4 * hh; const f32x4 w = *(const f32x4*)(hn + c_h * 128 + dv);
                    u32x2* mp = (u32x2*)(MO + (size_t)(c_rowbase + t) * 512 + c_h * 128 + dv); const u32x2 mo = *mp;
                    u32x2 o; o.x = pk2(H[dvb][4 * g] * rstd * w.x * bflo(mo.x), H[dvb][4 * g + 1] * rstd * w.y * bfhi(mo.x));
                    o.y = pk2(H[dvb][4 * g + 2] * rstd * w.z * bflo(mo.y), H[dvb][4 * g + 3] * rstd * w.w * bfhi(mo.y)); if (!dry || rstd == 12345.678f) *mp = o; }
        }
        __syncthreads();
    }
}

constexpr int AK_STR = 208;
constexpr int AV_STR = 136;
constexpr int A_KB = 64 * AK_STR, A_VB = 64 * AV_STR;
DI float max3f(float a, float b, float c) { float r; asm("v_max3_f32 %0, %1, %2, %3" : "=v"(r) : "v"(a), "v"(b), "v"(c)); return r; }
struct AStage { u32x4 k0, k1, v; };
DI void phase_attn(const Params& p, unsigned char* lds) {
    const int tid = tid_(), lane = tid & 63, wave = tid >> 6, hh = lane >> 5, l31 = lane & 31;
    unsigned char* ws = lp_(p.ws); unsigned char* dob = (unsigned char*)p.out;
    const bf16_t* Q = (const bf16_t*)(ws + WS_Q); const bf16_t* KN = (const bf16_t*)(ws + WS_KN); const bf16_t* KR = (const bf16_t*)(ws + WS_KR);
    const bf16_t* VT = (const bf16_t*)(dob + DO_VT); bf16_t* AO = (bf16_t*)(dob + DO_AO);
    const LAS char* L3 = (const LAS char*)lds;
    const int id1 = (tid + 512) % 768;
    const int kkey0 = tid / 12, kch0 = tid % 12, kkey1 = id1 / 12, kch1 = id1 % 12;
    const int vdv = tid >> 3, vch = tid & 7;
    for (int u = bid_(); u < 768; u += gridDim.x) {
        int qrow0, keybase, nkt, h;
        if (u < 512) {
            const int r = u >> 8, i = u & 255, xcd = i & 7, slot = i >> 3, bh = r * 16 + xcd * 2 + (slot >> 4), qb = slot & 15; h = bh & 7; const int b = bh >> 3;
            qrow0 = RC + b * 4096 + qb * 256; keybase = RC + b * 4608; nkt = 72; }
        else { const int v = u - 512; h = v & 7; const int b = v >> 3; qrow0 = b * 256; keybase = b * 256; nkt = 4; }
        const int qrow = qrow0 + wave * 32 + l31;
        bf16x8 qf[6];
#pragma unroll
        for (int ks = 0; ks < 6; ++ks) qf[ks] = *(const bf16x8*)(Q + (size_t)qrow * 768 + h * 96 + 16 * ks + 8 * hh);
        f32x16 O[2];
#pragma unroll
        for (int e = 0; e < 16; ++e) { O[0][e] = 0.f; O[1][e] = 0.f; }
        const bf16_t* kp0 = kch0 < 8 ? KN + (size_t)(keybase + kkey0) * 512 + h * 64 + kch0 * 8 : KR + (size_t)(keybase + kkey0) * 32 + (kch0 - 8) * 8;
        const bf16_t* kp1 = kch1 < 8 ? KN + (size_t)(keybase + kkey1) * 512 + h * 64 + kch1 * 8 : KR + (size_t)(keybase + kkey1) * 32 + (kch1 - 8) * 8;
        const int ks0 = kch0 < 8 ? 64 * 512 : 64 * 32, ks1 = kch1 < 8 ? 64 * 512 : 64 * 32;
        const bf16_t* vp0 = VT + (size_t)(h * 64 + vdv) * RK + keybase + vch * 8;
#define K_LOAD(st, kt) do { (st).k0 = *(const u32x4*)(kp0 + (size_t)(kt) * ks0); (st).k1 = *(const u32x4*)(kp1 + (size_t)(kt) * ks1); } while (0)
#define V_LOAD(st, kt) do { (st).v = *(const u32x4*)(vp0 + (kt) * 64); } while (0)
#define K_STORE(st, buf) do { unsigned char* b_ = lds + (buf) * A_KB; *(u32x4*)(b_ + kkey0 * AK_STR + kch0 * 16) = (st).k0; *(u32x4*)(b_ + kkey1 * AK_STR + kch1 * 16) = (st).k1; } while (0)
#define V_STORE(st, buf) do { unsigned char* b_ = lds + 2 * A_KB + (buf) * A_VB; u32x2 lo_, hi_; lo_.x = (st).v.x; lo_.y = (st).v.y; hi_.x = (st).v.z; hi_.y = (st).v.w; \
            *(u32x2*)(b_ + vdv * AV_STR + vch * 16) = lo_; *(u32x2*)(b_ + vdv * AV_STR + vch * 16 + 8) = hi_; } while (0)
#define QK_READ(buf) const LAS char* kb3_ = L3 + (buf) * A_KB; bf16x8 ka0[6], ka1[6]; \
            _Pragma("unroll") for (int ks = 0; ks < 6; ++ks) ka0[ks] = *(const LAS bf16x8*)(kb3_ + l31 * AK_STR + (16 * ks + 8 * hh) * 2); \
            _Pragma("unroll") for (int ks = 0; ks < 6; ++ks) ka1[ks] = *(const LAS bf16x8*)(kb3_ + (32 + l31) * AK_STR + (16 * ks + 8 * hh) * 2);
#define FIXUP(Sx, forced) do { \
            float tm = max3f(Sx[0][0], Sx[1][0], Sx[0][1]); \
            _Pragma("unroll") for (int e = 1; e < 15; e += 2) { tm = max3f(tm, Sx[1][e], Sx[0][e + 1]); tm = max3f(tm, Sx[1][e + 1], Sx[0][e + 2]); } \
            tm = fmaxf(tm, Sx[1][15]); tm = fmaxf(tm, __shfl_xor(tm, 32)); \
            if ((forced) || __builtin_amdgcn_ballot_w64(tm > 8.f) != 0ull) { \
                const float delta = (forced) ? tm : fmaxf(tm, 0.f); const float alpha = __builtin_amdgcn_exp2f(-delta); \
                _Pragma("unroll") for (int e = 0; e < 16; ++e) { Sx[0][e] -= delta; Sx[1][e] -= delta; O[0][e] *= alpha; O[1][e] *= alpha; Ol[e] *= alpha; } \
                mbase += delta; } } while (0)
        AStage RA;
        K_LOAD(RA, 0); V_LOAD(RA, 0); K_STORE(RA, 0); V_STORE(RA, 0);
        K_LOAD(RA, 1);
        __syncthreads();
        f32x16 S[2], Ol; float mbase = 0.f;
        bf16x8 ones;
#pragma unroll
        for (int e = 0; e < 8; ++e) ones[e] = (short)0x3f80;
#pragma unroll
        for (int e = 0; e < 16; ++e) { S[0][e] = 0.f; S[1][e] = 0.f; Ol[e] = 0.f; }
        { QK_READ(0)
#pragma unroll
          for (int ks = 0; ks < 6; ++ks) { S[0] = MFMA32(ka0[ks], qf[ks], S[0]); S[1] = MFMA32(ka1[ks], qf[ks], S[1]); } }
        FIXUP(S, true);
        K_STORE(RA, 1);
        __syncthreads();
        for (int kt = 0; kt < nkt; ++kt) {
            { const int kk = kt + 2 < nkt ? kt + 2 : nkt - 1, kv = kt + 1 < nkt ? kt + 1 : nkt - 1; K_LOAD(RA, kk); V_LOAD(RA, kv); }
            f32x16 Sn[2];
#pragma unroll
            for (int e = 0; e < 16; ++e) { Sn[0][e] = -mbase; Sn[1][e] = -mbase; }
            QK_READ((kt + 1) & 1)
            __builtin_amdgcn_sched_barrier(0);
            __builtin_amdgcn_s_setprio(1);
#pragma unroll
            for (int ks = 0; ks < 6; ++ks) Sn[0] = MFMA32(ka0[ks], qf[ks], Sn[0]);
#pragma unroll
            for (int e = 0; e < 16; ++e) S[0][e] = __builtin_amdgcn_exp2f(S[0][e]);
#pragma unroll
            for (int i2 = 0; i2 < 6; ++i2) { __builtin_amdgcn_sched_group_barrier(0x008, 1, 0); __builtin_amdgcn_sched_group_barrier(0x002, 3, 0); }
            __builtin_amdgcn_sched_barrier(0);
            const LAS char* vb3 = L3 + 2 * A_KB + (kt & 1) * A_VB;
            s16x4 va[2][2][2][2];
#pragma unroll
            for (int dvb = 0; dvb < 2; ++dvb)
#pragma unroll
                for (int kb = 0; kb < 2; ++kb)
#pragma unroll
                    for (int s2 = 0; s2 < 2; ++s2) { const LAS char* vp = vb3 + (dvb * 32 + l31) * AV_STR + (kb * 32 + 16 * s2 + 4 * hh) * 2;
                        va[dvb][kb][s2][0] = *(const LAS s16x4*)vp; va[dvb][kb][s2][1] = *(const LAS s16x4*)(vp + 16); }
            __builtin_amdgcn_sched_barrier(0);
#pragma unroll
            for (int ks = 0; ks < 6; ++ks) Sn[1] = MFMA32(ka1[ks], qf[ks], Sn[1]);
#pragma unroll
            for (int e = 0; e < 16; ++e) S[1][e] = __builtin_amdgcn_exp2f(S[1][e]);
            bf16x8 pb[2][2];
#pragma unroll
            for (int kb = 0; kb < 2; ++kb) { pb[kb][0] = pack8(S[kb], 0); pb[kb][1] = pack8(S[kb], 1); }
#pragma unroll
            for (int i2 = 0; i2 < 6; ++i2) { __builtin_amdgcn_sched_group_barrier(0x008, 1, 0); __builtin_amdgcn_sched_group_barrier(0x002, 6, 0); }
            __builtin_amdgcn_sched_barrier(0);
#pragma unroll
            for (int kb = 0; kb < 2; ++kb)
#pragma unroll
                for (int s2 = 0; s2 < 2; ++s2) {
                    O[0] = MFMA32(cat4(va[0][kb][s2][0], va[0][kb][s2][1]), pb[kb][s2], O[0]);
                    O[1] = MFMA32(cat4(va[1][kb][s2][0], va[1][kb][s2][1]), pb[kb][s2], O[1]);
                    Ol = MFMA32(ones, pb[kb][s2], Ol); }
            __builtin_amdgcn_s_setprio(0);
            K_STORE(RA, kt & 1); V_STORE(RA, (kt + 1) & 1);
            FIXUP(Sn, false);
            __syncthreads();
            S[0] = Sn[0]; S[1] = Sn[1];
        }
#undef QK_READ
#undef FIXUP
#undef K_LOAD
#undef V_LOAD
#undef K_STORE
#undef V_STORE
        const float linv = 1.f / Ol[0];
#pragma unroll
        for (int dvb = 0; dvb < 2; ++dvb)
#pragma unroll
            for (int g = 0; g < 4; ++g) { u32x2 o; o.x = pk2(O[dvb][4 * g] * linv, O[dvb][4 * g + 1] * linv); o.y = pk2(O[dvb][4 * g + 2] * linv, O[dvb][4 * g + 3] * linv);
                *(u32x2*)(AO + (size_t)qrow * 512 + h * 64 + dvb * 32 + 8 * g + 4 * hh) = o; }
    }
}

constexpr size_t WS_BAR = 512 * 1024;
#define XB_TMO      128
#define XB_XCNT(j)  (256  + 64 * (j))
#define XB_XSUB(j)  (1280 + 64 * (j))
#define XB_XGEN(j)  (2304 + 64 * (j))
#define XB_TOP      3328
#define XB_TOPGEN   3392
#define XCD_BAR_WORDS 3456
#define XB_SPIN_CAP (1u << 18)

__device__ __forceinline__ unsigned xb_ld(unsigned* p)              { return __hip_atomic_load(p, __ATOMIC_RELAXED, __HIP_MEMORY_SCOPE_AGENT); }
__device__ __forceinline__ unsigned xb_add(unsigned* p, unsigned v) { return __hip_atomic_fetch_add(p, v, __ATOMIC_RELAXED, __HIP_MEMORY_SCOPE_AGENT); }
__device__ __forceinline__ unsigned xb_xcc_id() { return (unsigned)__builtin_amdgcn_s_getreg((3 << 11) | 20) & 0xFu; }
#define XB_SPIN(cond, bar) do { unsigned _sp = 0; while (cond) { __builtin_amdgcn_s_sleep(1); \
    if ((++_sp & 255u) == 0u) { if (xb_ld(&(bar)[XB_TMO])) break; if (_sp > XB_SPIN_CAP) { atomicAdd(&(bar)[XB_TMO], 1u); break; } } } } while (0)

struct XcdBarrier {
    unsigned* bar; unsigned x;
    volatile LAS unsigned* st;
};

__device__ __forceinline__ XcdBarrier xcd_barrier_post(unsigned* bar, volatile LAS unsigned* st) {
    XcdBarrier b; b.bar = bar; b.x = xb_xcc_id(); b.st = st;
    if (threadIdx.x == 0) (void)xb_add(&bar[XB_XCNT(b.x)], 1u);
    return b;
}
__device__ __forceinline__ void xcd_barrier_complete(unsigned* bar, unsigned x, unsigned& nloc, unsigned& nx) {
    const unsigned G = gridDim.x * gridDim.y * gridDim.z;
    unsigned sum, cnt, mine, sp = 0u;
    for (;;) {
        sum = 0u; cnt = 0u; mine = 0u;
#pragma unroll
        for (unsigned j = 0; j < 16; ++j) { const unsigned c = xb_ld(&bar[XB_XCNT(j)]); sum += c; cnt += (c > 0u) ? 1u : 0u; mine = (j == x) ? c : mine; }
        if (sum == G) break;
        __builtin_amdgcn_s_sleep(1);
        if ((++sp & 255u) == 0u) { if (xb_ld(&bar[XB_TMO])) break; if (sp > XB_SPIN_CAP) { atomicAdd(&bar[XB_TMO], 1u); break; } }
    }
    nloc = mine > 0u ? mine : 1u; nx = cnt > 0u ? cnt : 1u;
}

__device__ __forceinline__ void xcd_barrier(const XcdBarrier& b) {
    asm volatile("s_waitcnt vmcnt(0)" ::: "memory");
    __syncthreads();
    if (threadIdx.x == 0) {
        unsigned* bar = b.bar;
        __builtin_amdgcn_s_waitcnt(0);
        unsigned nloc = b.st[0], nx = b.st[1];
        if (nloc == 0u) { xcd_barrier_complete(bar, b.x, nloc, nx); b.st[0] = nloc; b.st[1] = nx; }
        const unsigned old = xb_add(&bar[XB_XSUB(b.x)], 1u);
        const unsigned gen = old / nloc;
        if (old + 1u == (gen + 1u) * nloc) {
            __builtin_amdgcn_fence(__ATOMIC_RELEASE, "agent");
            asm volatile("s_waitcnt vmcnt(0)" ::: "memory");
            const unsigned og = xb_add(&bar[XB_TOP], 1u);
            const unsigned tg = og / nx;
            if (og + 1u == (tg + 1u) * nx) xb_add(&bar[XB_TOPGEN], 1u);
            else XB_SPIN(xb_ld(&bar[XB_TOPGEN]) == tg, bar);
            __builtin_amdgcn_fence(__ATOMIC_ACQUIRE, "agent");
            xb_add(&bar[XB_XGEN(b.x)], 1u);
            asm volatile("s_waitcnt vmcnt(0)" ::: "memory");
        } else {
            XB_SPIN(xb_ld(&bar[XB_XGEN(b.x)]) == gen, bar);
            __builtin_amdgcn_fence(__ATOMIC_ACQUIRE, "agent");
            asm volatile("s_waitcnt vmcnt(0)" ::: "memory");
        }
    }
    __syncthreads();
}

constexpr int LDS_BYTES = 147456;
constexpr int N_PHASES = 16;
#ifndef PM
#define PM 0x1FFFF
#endif
#define PH(k) ((PM >> (k)) & 1)
#ifndef DUP
#define DUP 0
#endif
#define DP(k) ((DUP >> (k)) & 1)
__global__ void __launch_bounds__(NT, 2) fwd_kernel(Params p_) {
    Params p = p_;
    p.ws = gp_(p_.ws); p.out = gp_(p_.out);
#pragma unroll
    for (int i = 0; i < 27; ++i) p.in[i] = gp_(p_.in[i]);
    extern __shared__ __attribute__((aligned(16))) unsigned char lds[];
    cg::grid_group grid = cg::this_grid();
    unsigned char* ws = lp_(p.ws); unsigned char* dob = (unsigned char*)p.out;
    const int lo = p.ph_lo, hi = p.ph_hi;
    unsigned* barw = (unsigned*)(ws + WS_BAR);
    volatile LAS unsigned* xst = (volatile LAS unsigned*)((LAS unsigned char*)lds + (LDS_BYTES - 64));
    if (tid_() == 0) { xst[0] = 0u; xst[1] = 0u; }
    if (blockIdx.x == 0) { for (int i = tid_(); i < XCD_BAR_WORDS; i += NT) __hip_atomic_store(barw + i, 0u, __ATOMIC_RELAXED, __HIP_MEMORY_SCOPE_AGENT); }
    XcdBarrier xbar; xbar.bar = barw; xbar.x = 0; xbar.st = xst;
#define GSYNC(k) do { if ((k) == lo + 2) { grid.sync(); xbar = xcd_barrier_post(barw, xst); } else xcd_barrier(xbar); } while (0)
#define IN(k) (lo <= (k) && (k) < hi)
#define SEAM(k) do { if (IN(k) && (k) > lo) GSYNC(k); } while (0)
#define RUN_GEMMS(G0, G1) do { if (PH(16)) for (int gi = (G0); gi < (G1); ++gi) { \
            pg8::Gemm g; EpiGen E; E.ws = ws; E.dout = p.out; E.gate_b = p.in[16]; E.ldc = 0; E.hstride = 0; E.out = ws; E.mode = EM_BF16; int boff = 0; \
            const bf16_t* H2 = (const bf16_t*)(ws + WS_H2); \
            switch (gi) { \
            case 0: g = {(const bf16_t*)(dob + DO_H1), (const bf16_t*)(ws + WS_WIN), R, NIN, 1024}; E.mode = EM_IN; break; \
            case 1: g = {(const bf16_t*)(ws + WS_CQ), (const bf16_t*)(ws + WS_WUQ), R, 768, 384}; E.mode = EM_Q; E.out = ws + WS_Q; break; \
            case 2: g = {(const bf16_t*)(dob + DO_KC), (const bf16_t*)(ws + WS_WUK), RK, 512, 256}; E.mode = EM_BF16; E.out = ws + WS_KN; E.ldc = 512; boff = 224; break; \
            case 3: g = {(const bf16_t*)(ws + WS_WV), (const bf16_t*)(dob + DO_KC), 512, RK, 256}; E.mode = EM_BF16; E.out = dob + DO_VT; E.ldc = RK; boff = 208; break; \
            case 4: g = {(const bf16_t*)(ws + WS_MO), (const bf16_t*)(ws + WS_WOM), R, 1024, 512}; E.mode = EM_G1; E.out = ws + WS_Z; break; \
            case 5: g = {(const bf16_t*)(dob + DO_AO), (const bf16_t*)(ws + WS_WOA), R, 1024, 512}; E.mode = EM_G2; E.out = ws + WS_Z; break; \
            case 6: g = {(const bf16_t*)(ws + WS_Z), (const bf16_t*)(ws + WS_WOUT), R, 1024, 1024}; E.mode = EM_BF16; E.out = ws + WS_MG; E.ldc = 1024; break; \
            case 7: g = {H2 + (size_t)RA_ROWS * 1024, (const bf16_t*)(ws + WS_W1), RB_ROWS, 4096, 1024}; E.mode = EM_RELU2; E.out = ws + WS_F1; E.hstride = (size_t)RB_ROWS * 2048; break; \
            case 8: g = {(const bf16_t*)(ws + WS_F1), (const bf16_t*)(ws + WS_W2), RB_ROWS, 1024, 2048}; E.mode = EM_BF16; E.out = ws + WS_P0; E.ldc = 1024; break; \
            case 9: g = {(const bf16_t*)(ws + WS_F1) + (size_t)RB_ROWS * 2048, (const bf16_t*)(ws + WS_W2) + (size_t)1024 * 2048, RB_ROWS, 1024, 2048}; E.mode = EM_BF16; E.out = ws + WS_P1; E.ldc = 1024; boff = 128; break; \
            case 10: g = {H2, (const bf16_t*)(ws + WS_W1), RA_ROWS, 4096, 1024}; E.mode = EM_RELU2; E.out = ws + WS_F1; E.hstride = (size_t)RA_ROWS * 2048; break; \
            case 11: g = {(const bf16_t*)(ws + WS_F1), (const bf16_t*)(ws + WS_W2), RA_ROWS, 1024, 2048}; E.mode = EM_BF16; E.out = ws + WS_P0; E.ldc = 1024; break; \
            default: g = {(const bf16_t*)(ws + WS_F1) + (size_t)RA_ROWS * 2048, (const bf16_t*)(ws + WS_W2) + (size_t)1024 * 2048, RA_ROWS, 1024, 2048}; E.mode = EM_ADD; E.out = ws + WS_P0; E.ldc = 1024; break; \
            } \
            __syncthreads(); \
            pg8::StaticOrder S; S.init(g.M, g.N, (int)gridDim.x, (bid_() + boff) % (int)gridDim.x); \
            pg8::gemm_phase<EpiGen, pg8::StaticOrder, true, true>((PG8_LAS unsigned char*)lds, g, S, E); \
            __syncthreads(); \
        } } while (0)
    if (IN(0)) { if (PH(0)) { phase_A(p, lds, false); __syncthreads(); phase_A(p, lds, true); } if (IN(1) && PH(1)) { __syncthreads(); phase_B(p); } }
    if (IN(1) && !IN(0)) { if (PH(1)) phase_B(p); }
    if (DP(20)) { for (int i = 0; i < 10; ++i) xcd_barrier(xbar); }
    SEAM(2); if (IN(2)) { RUN_GEMMS(0, 1); if (DP(2)) RUN_GEMMS(0, 1); }
    SEAM(3); if (IN(3)) { if (PH(3)) { phase_M1(p, lds); if (DP(3)) phase_M1(p, lds); phase_D(p); } }
    SEAM(4); if (IN(4)) { if (PH(4)) { phase_M2(p, lds); __syncthreads(); phase_M3(p, lds, false, bid_() >= 128 ? bid_() - 128 : -1, 256, 128); } }
    SEAM(5); if (IN(5)) { if (PH(5)) phase_M3(p, lds, false, 256 + bid_(), 768, (int)gridDim.x); }
    SEAM(6); if (IN(6)) { RUN_GEMMS(1, 4); if (DP(6)) RUN_GEMMS(1, 4); }
    SEAM(7); if (IN(7)) { if (PH(7)) phase_attn(p, lds); if (DP(7)) phase_attn(p, lds); }
    for (int ph = (lo > 8 ? lo : 8); ph < hi; ++ph) {
        if (ph > lo) GSYNC(ph);
        int g0 = 0, g1 = 0;
        switch (ph) {
        case 8: g0 = 4; g1 = 6; break;
        case 9: g0 = 6; g1 = 7; break;
        case 10: if (PH(10)) phase_I(p); if (DP(10)) phase_I(p); break;
        case 11: g0 = 7; g1 = 8; break;
        case 12: g0 = 8; g1 = 10; break;
        case 13: if (DP(21)) phase_L(p, RA_ROWS, RB_ROWS, (const bf16_t*)(ws + WS_P0), (const bf16_t*)(ws + WS_P1), true);
                 if (PH(13)) phase_L(p, RA_ROWS, RB_ROWS, (const bf16_t*)(ws + WS_P0), (const bf16_t*)(ws + WS_P1)); g0 = 10; g1 = 11; break;
        case 14: g0 = 11; g1 = 13; break;
        case 15: if (DP(21)) phase_L(p, 0, RA_ROWS, (const bf16_t*)(ws + WS_P0), nullptr, true);
                 if (PH(15)) phase_L(p, 0, RA_ROWS, (const bf16_t*)(ws + WS_P0), nullptr); break;
        }
        RUN_GEMMS(g0, g1);
        if ((DUP >> ph) & 1) RUN_GEMMS(g0, g1);
    }
}

extern "C" void kernel_launch(void* const* d_in, const int* in_sizes, int n_in, void* d_out, int out_size, void* d_ws, size_t ws_size, hipStream_t stream) {
    static int grid = 0;
    if (grid == 0) {
        int dev = 0, cus = 0, per_cu = 0;
        hipGetDevice(&dev); hipDeviceGetAttribute(&cus, hipDeviceAttributeMultiprocessorCount, dev);
        if (hipFuncSetAttribute((const void*)fwd_kernel, hipFuncAttributeMaxDynamicSharedMemorySize, LDS_BYTES) != hipSuccess) fprintf(stderr, "kernel_launch: hipFuncSetAttribute failed\n");
        if (hipOccupancyMaxActiveBlocksPerMultiprocessor(&per_cu, (const void*)fwd_kernel, NT, LDS_BYTES) != hipSuccess || per_cu < 1) { fprintf(stderr, "kernel_launch: occupancy query says %d\n", per_cu); per_cu = 1; }
        (void)hipGetLastError();
        grid = cus * 1;
        if (n_in != 27 || ws_size < WS_END) fprintf(stderr, "kernel_launch: unexpected n_in %d / ws_size %zu\n", n_in, ws_size);
    }
    (void)hipMemsetAsync((unsigned char*)d_ws + WS_ADACNT, 0, 256, stream);
    Params p{};
    for (int i = 0; i < 27; ++i) p.in[i] = (const float*)d_in[i];
    p.out = (float*)d_out; p.ws = (unsigned char*)d_ws;
#ifndef MK_SPLIT
    p.ph_lo = 0; p.ph_hi = N_PHASES;
    void* args[] = {&p};
    hipError_t e = hipLaunchCooperativeKernel((const void*)fwd_kernel, dim3(grid), dim3(NT), args, LDS_BYTES, stream);
    if (e != hipSuccess) fprintf(stderr, "cooperative launch failed: %s (grid %d)\n", hipGetErrorString(e), grid);
#else
    for (int ph = 0; ph < N_PHASES; ++ph) { p.ph_lo = ph; p.ph_hi = ph + 1; hipLaunchKernelGGL(fwd_kernel, dim3(grid), dim3(NT), LDS_BYTES, stream, p); }
#endif
}
```

```cpp
#include <hip/hip_runtime.h>
#include <hip/hip_cooperative_groups.h>
#include <cstdio>
#include <cstdint>
#include <utility>
namespace cg = cooperative_groups;
__device__ __forceinline__ int tid_() { int t = threadIdx.x; asm volatile("" : "+v"(t)); return t; }
__device__ __forceinline__ int bid_() { int b = blockIdx.x; asm volatile("" : "+s"(b)); return b; }
template <class T> __device__ __forceinline__ T* gp_(T* q) { return (T*)(__attribute__((address_space(1))) T*)q; }
template <class T> __device__ __forceinline__ T* lp_(T* q) { return q; }
namespace pg8 {
#define PG8_LAS __attribute__((address_space(3)))
typedef unsigned short bf16_t;
typedef short bf16x8 __attribute__((ext_vector_type(8)));
typedef float f32x4 __attribute__((ext_vector_type(4)));
typedef unsigned u32x4 __attribute__((ext_vector_type(4)));
constexpr int BM = 256, BK = 64, HALF = 128, HTB = HALF * BK * 2  , STAGE_BYTES = 8 * HTB, NXCD = 8, WGM = 8;

__host__ __device__ __forceinline__ int lds_byte(int r, int c) { const int st = (r >> 4) * 2 + (c >> 5), rr = r & 15, cc = c & 31, ob = rr * 64 + cc * 2; return st * 1024 + (ob ^ (((ob >> 9) & 1) << 5)); }
__host__ __device__ __forceinline__ void stage_rc(int b, int& R, int& C) { const int st = b / 1024, sb = b % 1024, swz = sb ^ (((sb >> 9) & 1) << 5); R = (st >> 1) * 16 + swz / 64; C = (st & 1) * 32 + (swz % 64) / 2; }
__host__ __device__ __forceinline__ int perm32(int rho) { const int n = rho >> 4, i = rho & 15; return 8 * (i >> 2) + 4 * n + (i & 3); }

struct Unit { int pm, pn; };
struct Gemm { const bf16_t* A; const bf16_t* Bt; int M, N, K; };

struct StaticOrder {
    int nM, nN, nwg, G, c;
    __host__ __device__ void init(int M, int N, int G_, int c_) { nM = M / BM; nN = N / BM; nwg = nM * nN; G = G_; c = c_; }
    __host__ __device__ bool next(int i, Unit& u) const {
        const long L = (long)i * G + c; if (L >= nwg) return false;
        int wgid = (int)L; { const int q = nwg / NXCD, r = nwg % NXCD, xcd = wgid % NXCD, off = wgid / NXCD; wgid = (xcd < r ? xcd * (q + 1) : r * (q + 1) + (xcd - r) * q) + off; }
        const int nig = WGM * nN, gid = wgid / nig, fm = gid * WGM, gsz = (nM - fm) < WGM ? (nM - fm) : WGM;
        u.pm = fm + ((wgid % nig) % gsz); u.pn = (wgid % nig) / gsz; return true;
    }
    __device__ __forceinline__ void a_ready(const Unit&) const {}
    __device__ __forceinline__ void done(const Unit&) const {}
};
__device__ __forceinline__ unsigned cvt_pk_bf16(float lo, float hi) { unsigned r; asm volatile("v_cvt_pk_bf16_f32 %0, %1, %2" : "=v"(r) : "v"(lo), "v"(hi)); return r; }
template <class Epi, class Sched, bool ALIGN_EPI = false, bool SP2 = false>
__device__ __forceinline__ void gemm_phase(PG8_LAS unsigned char* lds, const Gemm g, const Sched& S, const Epi& E) {
    const int tid = tid_(), wid = __builtin_amdgcn_readfirstlane(tid >> 6), lane = tid & 63, wr = wid >> 2, wc = wid & 3, fr = lane & 15, fq = lane >> 4;
    const int K = g.K, nt = K / BK;
    unsigned voffA[2], voffB[2];
#pragma unroll
    for (int i = 0; i < 2; ++i) { int R, C; stage_rc(tid * 16 + i * 8192, R, C); const int Rb = Epi::PERM ? ((R & ~31) + perm32(R & 31)) : R;
        voffA[i] = (unsigned)(R * K + C) * 2u; voffB[i] = (unsigned)(Rb * K + C) * 2u; }
    const size_t kstep = (size_t)(BK * 2);
    const size_t hstep = (size_t)HALF * K * 2;
    const size_t tstep = 2 * hstep;
    const unsigned ldsw = (unsigned)wid * 1024u;
    const int aoff = lds_byte(wr * 64 + fr, fq * 8), boff = lds_byte(wc * 32 + fr, fq * 8);
#define PG8_SA(b, h) (((b) * 2 + (h)) * HTB)
#define PG8_SB(b, h) ((4 + (b) * 2 + (h)) * HTB)
#define PG8_STAGE(bufoff, gbase, voff) do { _Pragma("unroll") for (int _i = 0; _i < 2; ++_i) \
        __builtin_amdgcn_global_load_lds((const unsigned*)((const char*)(gbase) + (voff)[_i]), (PG8_LAS unsigned*)(lds + (bufoff) + ldsw + _i * 8192), 16, 0, 0); } while (0)
#define PG8_LDA(dst, b, h) do { _Pragma("unroll") for (int m = 0; m < 4; ++m) _Pragma("unroll") for (int k = 0; k < 2; ++k) dst[m][k] = *(const PG8_LAS bf16x8*)(lds + PG8_SA(b, h) + aoff + m * 2048 + k * 1024); } while (0)
#define PG8_LDB(dst, b, h) do { _Pragma("unroll") for (int n = 0; n < 2; ++n) _Pragma("unroll") for (int k = 0; k < 2; ++k) dst[n][k] = *(const PG8_LAS bf16x8*)(lds + PG8_SB(b, h) + boff + n * 2048 + k * 1024); } while (0)
#define PG8_MMA(ai, bj, At, Bt) do { __builtin_amdgcn_s_setprio(1); _Pragma("unroll") for (int m = 0; m < 4; ++m) _Pragma("unroll") for (int n = 0; n < 2; ++n) _Pragma("unroll") for (int k = 0; k < 2; ++k) \
        acc[ai][bj][m][n] = __builtin_amdgcn_mfma_f32_16x16x32_bf16(Bt[n][k], At[m][k], acc[ai][bj][m][n], 0, 0, 0); __builtin_amdgcn_s_setprio(0); } while (0)
#define PG8_WAIT_V(n) asm volatile("s_waitcnt vmcnt(" #n ")" ::: "memory")
#define PG8_WAIT_L(n) asm volatile("s_waitcnt lgkmcnt(" #n ")" ::: "memory")
#define PG8_BAR __builtin_amdgcn_s_barrier()
#define PG8_SCHED __builtin_amdgcn_sched_barrier(0)
    Unit cur, nxt; int ui = 0;
    if (!S.next(0, cur)) return;
    f32x4 acc[2][2][4][2];
#pragma unroll
    for (int a = 0; a < 2; ++a)
#pragma unroll
        for (int b = 0; b < 2; ++b)
#pragma unroll
            for (int m = 0; m < 4; ++m)
#pragma unroll
                for (int n = 0; n < 2; ++n) acc[a][b][m][n] = (f32x4){0.f, 0.f, 0.f, 0.f};
    bf16x8 At[4][2], B0[2][2], B1[2][2];
    const char* cA = (const char*)g.A + (size_t)cur.pm * tstep; const char* cB = (const char*)g.Bt + (size_t)cur.pn * tstep;
    S.a_ready(cur);
    if constexpr (SP2) {
        PG8_STAGE(PG8_SB(0, 0), cB, voffB); PG8_STAGE(PG8_SB(0, 1), cB + hstep, voffB); PG8_STAGE(PG8_SA(0, 0), cA, voffA); PG8_STAGE(PG8_SA(0, 1), cA + hstep, voffA);
        if (wr == 1) PG8_BAR;
        PG8_WAIT_V(2); PG8_BAR;
        PG8_STAGE(PG8_SB(1, 0), cB + kstep, voffB); PG8_STAGE(PG8_SA(1, 0), cA + kstep, voffA); PG8_STAGE(PG8_SB(1, 1), cB + hstep + kstep, voffB);
        PG8_WAIT_V(6); PG8_BAR;
    } else {
        PG8_STAGE(PG8_SB(0, 0), cB, voffB); PG8_STAGE(PG8_SA(0, 0), cA, voffA); PG8_STAGE(PG8_SB(0, 1), cB + hstep, voffB); PG8_STAGE(PG8_SA(0, 1), cA + hstep, voffA);
        if (wr == 1) PG8_BAR;
        PG8_WAIT_V(4); PG8_BAR;
        PG8_STAGE(PG8_SB(1, 0), cB + kstep, voffB); PG8_STAGE(PG8_SA(1, 0), cA + kstep, voffA); PG8_STAGE(PG8_SB(1, 1), cB + hstep + kstep, voffB);
        PG8_WAIT_V(6); PG8_BAR;
    }
    for (;;) {
        const bool has_next = S.next(ui + 1, nxt);
        const char* nA = has_next ? (const char*)g.A + (size_t)nxt.pm * tstep : cA; const char* nB = has_next ? (const char*)g.Bt + (size_t)nxt.pn * tstep : cB;
        for (int t = 0; t < nt; t += 2) {
            const bool last = (t == nt - 2);
            const char* a1 = cA + (size_t)(t + 1) * kstep;
            const char* a2 = last ? nA : cA + (size_t)(t + 2) * kstep; const char* b2 = last ? nB : cB + (size_t)(t + 2) * kstep;
            const char* a3 = a2 + kstep; const char* b3 = b2 + kstep;
            if (last && has_next) S.a_ready(nxt);
            if constexpr (SP2) {
            PG8_LDB(B0, 0, 0); PG8_LDB(B1, 0, 1); PG8_SCHED; PG8_LDA(At, 0, 0); PG8_STAGE(PG8_SA(1, 1), a1 + hstep, voffA);
            PG8_WAIT_V(8); PG8_WAIT_L(0); PG8_BAR; PG8_MMA(0, 0, At, B0); PG8_MMA(0, 1, At, B1); PG8_BAR; PG8_SCHED;
            PG8_LDA(At, 0, 1); PG8_STAGE(PG8_SB(0, 0), b2, voffB); PG8_STAGE(PG8_SB(0, 1), b2 + hstep, voffB); PG8_STAGE(PG8_SA(0, 0), a2, voffA);
            PG8_WAIT_V(8); PG8_WAIT_L(0); PG8_BAR; PG8_MMA(1, 0, At, B0); PG8_MMA(1, 1, At, B1); PG8_BAR; PG8_SCHED;
            PG8_LDB(B0, 1, 0); PG8_LDB(B1, 1, 1); PG8_SCHED; PG8_LDA(At, 1, 0); PG8_STAGE(PG8_SA(0, 1), a2 + hstep, voffA);
            PG8_WAIT_V(8); PG8_WAIT_L(0); PG8_BAR; PG8_MMA(0, 0, At, B0); PG8_MMA(0, 1, At, B1); PG8_BAR; PG8_SCHED;
            PG8_LDA(At, 1, 1); PG8_STAGE(PG8_SB(1, 0), b3, voffB); PG8_STAGE(PG8_SB(1, 1), b3 + hstep, voffB); PG8_STAGE(PG8_SA(1, 0), a3, voffA);
            PG8_WAIT_V(8); PG8_WAIT_L(0); PG8_BAR; PG8_MMA(1, 0, At, B0); PG8_MMA(1, 1, At, B1); PG8_BAR; PG8_SCHED;
            } else {
            PG8_LDB(B0, 0, 0); PG8_SCHED; PG8_LDA(At, 0, 0); PG8_STAGE(PG8_SA(1, 1), a1 + hstep, voffA);
            PG8_WAIT_L(8); PG8_BAR; PG8_WAIT_L(0); PG8_MMA(0, 0, At, B0); PG8_BAR; PG8_SCHED;
            PG8_LDB(B1, 0, 1); PG8_STAGE(PG8_SB(0, 0), b2, voffB);
            PG8_BAR; PG8_WAIT_L(0); PG8_MMA(0, 1, At, B1); PG8_BAR;
            PG8_LDA(At, 0, 1); PG8_STAGE(PG8_SA(0, 0), a2, voffA);
            PG8_BAR; PG8_WAIT_L(0); PG8_MMA(1, 0, At, B0); PG8_BAR; PG8_SCHED;
            PG8_STAGE(PG8_SB(0, 1), b2 + hstep, voffB);
            PG8_WAIT_V(6); PG8_BAR; PG8_MMA(1, 1, At, B1); PG8_BAR;
            PG8_LDB(B0, 1, 0); PG8_SCHED; PG8_LDA(At, 1, 0); PG8_STAGE(PG8_SA(0, 1), a2 + hstep, voffA);
            PG8_WAIT_L(8); PG8_BAR; PG8_WAIT_L(0); PG8_MMA(0, 0, At, B0); PG8_BAR; PG8_SCHED;
            PG8_LDB(B1, 1, 1); PG8_STAGE(PG8_SB(1, 0), b3, voffB);
            PG8_BAR; PG8_WAIT_L(0); PG8_MMA(0, 1, At, B1); PG8_BAR;
            PG8_LDA(At, 1, 1); PG8_STAGE(PG8_SA(1, 0), a3, voffA);
            PG8_BAR; PG8_WAIT_L(0); PG8_MMA(1, 0, At, B0); PG8_BAR; PG8_SCHED;
            PG8_STAGE(PG8_SB(1, 1), b3 + hstep, voffB);
            PG8_WAIT_V(6); PG8_BAR; PG8_MMA(1, 1, At, B1); PG8_BAR;
            }
        }
        if constexpr (ALIGN_EPI) { if (wr == 0) PG8_BAR; }
        if constexpr (!Epi::AFTER_DRAIN) { E(acc, cur, wr, wc, fr, fq); S.done(cur); }
        if (!has_next) break;
#pragma unroll
        for (int a = 0; a < 2; ++a)
#pragma unroll
            for (int b = 0; b < 2; ++b)
#pragma unroll
                for (int m = 0; m < 4; ++m)
#pragma unroll
                    for (int n = 0; n < 2; ++n) acc[a][b][m][n] = (f32x4){0.f, 0.f, 0.f, 0.f};
        cur = nxt; cA = nA; cB = nB; ++ui;
        if constexpr (ALIGN_EPI) { if (wr == 1) PG8_BAR; }
    }
    PG8_WAIT_V(0);
    if constexpr (!ALIGN_EPI) { if (wr == 0) PG8_BAR; }
    PG8_BAR;
    if constexpr (Epi::AFTER_DRAIN) { E.fused(acc, cur, wr, wc, fr, fq, lds, wid, lane); S.done(cur); }
#undef PG8_SA
#undef PG8_SB
#undef PG8_STAGE
#undef PG8_LDA
#undef PG8_LDB
#undef PG8_MMA
#undef PG8_WAIT_V
#undef PG8_WAIT_L
#undef PG8_BAR
#undef PG8_SCHED
}
}

typedef unsigned short bf16_t;
typedef short bf16x8 __attribute__((ext_vector_type(8)));
typedef short s16x4 __attribute__((ext_vector_type(4)));
typedef float f32x4 __attribute__((ext_vector_type(4)));
typedef float f32x16 __attribute__((ext_vector_type(16)));
typedef unsigned u32x4 __attribute__((ext_vector_type(4)));
typedef unsigned u32x2 __attribute__((ext_vector_type(2)));
#define LAS __attribute__((address_space(3)))
#define DI __device__ __forceinline__

constexpr int NT = 512;
constexpr int R = 24576, RC = 8192, RK = 26624;
constexpr int DM = 1024, NIN = 4864;
constexpr size_t MiB = 1u << 20;
constexpr size_t WS_MOD = 0;
constexpr size_t WS_ROPE = 128 * 1024;
constexpr size_t WS_SC = 256 * 1024;
constexpr size_t WS_MP = 384 * 1024;
constexpr size_t WS_ADACNT = 768 * 1024;
constexpr size_t WS_NST = 1 * MiB;
constexpr size_t WS_GATES = 6 * MiB;
constexpr size_t WS_KRRAW = 8 * MiB;
constexpr size_t WS_WIN = 11 * MiB;
constexpr size_t WS_W1 = WS_WIN + (size_t)NIN * 1024 * 2;
constexpr size_t WS_W2 = WS_W1 + 8 * MiB;
constexpr size_t WS_WOUT = WS_W2 + 8 * MiB;
constexpr size_t WS_WOA = WS_WOUT + 2 * MiB;
constexpr size_t WS_WOM = WS_WOA + 1 * MiB;
constexpr size_t WS_WUQ = WS_WOM + 1 * MiB;
constexpr size_t WS_WUK = WS_WUQ + 768 * 384 * 2;
constexpr size_t WS_WV = WS_WUK + 512 * 256 * 2;
static_assert(WS_WV + 512 * 256 * 2 <= 42 * MiB, "weights");
constexpr size_t WS_MQKV = 42 * MiB;
constexpr size_t WS_Q = 42 * MiB;
constexpr size_t WS_KN = 78 * MiB;
constexpr size_t WS_Z = 42 * MiB;
constexpr size_t WS_H2 = 208 * MiB;
constexpr size_t WS_P0 = 42 * MiB, WS_P1 = 58 * MiB;
constexpr size_t WS_F1 = 74 * MiB;
constexpr int RA_ROWS = 16384, RB_ROWS = 8192;
constexpr size_t WS_MO = 114 * MiB;
constexpr size_t WS_MG = 138 * MiB;
constexpr size_t WS_CQ = 234 * MiB;
constexpr size_t WS_KR = 252 * MiB;
constexpr size_t WS_END = 256 * MiB;
constexpr size_t DO_H1 = 0;
constexpr size_t DO_SLOT = 0;
constexpr size_t DO_VT = 0;
constexpr size_t DO_AO = 26 * MiB;
constexpr size_t DO_CKV = 48 * MiB;
constexpr size_t DO_KC = 60 * MiB;
constexpr size_t OUT_CKV = 25165824, OUT_KROPE = 27262976, OUT_C = 27525120, OUT_N = 31719424, OUT_M = 31752192;

struct Params {
    const float* in[27];
    float* out; unsigned char* ws;
    int ph_lo, ph_hi;
};

DI unsigned pk2(float lo, float hi) { unsigned r; asm volatile("v_cvt_pk_bf16_f32 %0, %1, %2" : "=v"(r) : "v"(lo), "v"(hi)); return r; }
DI float bflo(unsigned u) { return __uint_as_float(u << 16); }
DI float bfhi(unsigned u) { return __uint_as_float(u & 0xffff0000u); }
DI float bf1(bf16_t u) { return __uint_as_float(((unsigned)u) << 16); }
DI float sigmoidf_(float x) { return __builtin_amdgcn_rcpf(1.f + __expf(-x)); }
DI float wave_sum(float v) {
#pragma unroll
    for (int o = 1; o < 64; o <<= 1) v += __shfl_xor(v, o);
    return v;
}
DI float wave_max(float v) {
#pragma unroll
    for (int o = 1; o < 64; o <<= 1) v = fmaxf(v, __shfl_xor(v, o));
    return v;
}
DI int crow(int reg, int h) { return (reg & 3) + 8 * (reg >> 2) + 4 * h; }
DI s16x4 tr_read(const LAS char* p) { return __builtin_bit_cast(s16x4, __builtin_amdgcn_ds_read_tr16_b64_v4i16((LAS s16x4*)p)); }
DI bf16x8 cat4(s16x4 a, s16x4 b) { bf16x8 r; r[0] = a[0]; r[1] = a[1]; r[2] = a[2]; r[3] = a[3]; r[4] = b[0]; r[5] = b[1]; r[6] = b[2]; r[7] = b[3]; return r; }
#define MFMA32(a, b, c) __builtin_amdgcn_mfma_f32_32x32x16_bf16((a), (b), (c), 0, 0, 0)
DI bf16x8 pack8(const f32x16& x, int s) {
    u32x4 p; p[0] = pk2(x[8 * s], x[8 * s + 1]); p[1] = pk2(x[8 * s + 2], x[8 * s + 3]); p[2] = pk2(x[8 * s + 4], x[8 * s + 5]); p[3] = pk2(x[8 * s + 6], x[8 * s + 7]);
    return __builtin_bit_cast(bf16x8, p);
}

enum { EM_IN = 0, EM_Q, EM_BF16, EM_G1, EM_G2, EM_F32, EM_RELU2, EM_ADD };
struct EpiGen {
    static constexpr bool PERM = true, AFTER_DRAIN = false;
    int mode; int ldc; size_t hstride;
    void* out;
    unsigned char* ws; float* dout; const float* gate_b;
    DI void st8bf(bf16_t* p, f32x4 a, f32x4 b) const { u32x4 w; w.x = pk2(a[0], a[1]); w.y = pk2(a[2], a[3]); w.z = pk2(b[0], b[1]); w.w = pk2(b[2], b[3]); *(u32x4*)p = w; }
    template <int MODE> DI void one(int row, int col, int pn, f32x4 v0, f32x4 v1) const {
        switch (MODE) {
        case EM_IN: {
            if (pn < 6) {
                const float sc = pn < 2 ? 0.08838834764831845f : 1.f;
                st8bf((bf16_t*)(ws + WS_MQKV) + (size_t)row * 1536 + col, v0 * sc, v1 * sc);
            } else if (pn < 8) {
#pragma unroll
                for (int e = 0; e < 4; ++e) { v0[e] = sigmoidf_(v0[e]); v1[e] = sigmoidf_(v1[e]); }
                st8bf((bf16_t*)(ws + WS_MO) + (size_t)row * 512 + (col - 1536), v0, v1);
            } else if (pn < 11) {
                const int cl = col - 2048;
                if (cl < 384) st8bf((bf16_t*)(ws + WS_CQ) + (size_t)row * 384 + cl, v0, v1);
                else if (cl < 416) { float* d = (float*)(ws + WS_KRRAW) + (size_t)row * 32 + (cl - 384); *(f32x4*)d = v0; *(f32x4*)(d + 4) = v1; }
                else if (cl < 432) {
                    const int gi = cl - 416; f32x4 bi = *(const f32x4*)(gate_b + gi), bfv = *(const f32x4*)(gate_b + gi + 4);
                    f32x4 li = v0 + bi, x = v1 + bfv, lf;
#pragma unroll
                    for (int e = 0; e < 4; ++e) lf[e] = x[e] < -20.f ? x[e] : -__logf(1.f + __expf(-x[e]));
                    float* d = (float*)(ws + WS_GATES) + (size_t)row * 16 + gi; *(f32x4*)d = li; *(f32x4*)(d + 4) = lf;
                } else if (cl < 512) { }
                else st8bf((bf16_t*)((unsigned char*)dout + DO_CKV) + (size_t)row * 256 + (cl - 512), v0, v1);
            } else {
#pragma unroll
                for (int e = 0; e < 4; ++e) { v0[e] = sigmoidf_(v0[e]); v1[e] = sigmoidf_(v1[e]); }
                st8bf((bf16_t*)(ws + WS_MG) + (size_t)row * 2048 + (col - 2816), v0, v1);
            }
        } break;
        case EM_Q: {
            const float sc = 0.10206207261596577f * 1.4426950408889634f;
            const int d = col % 96;
            if (row >= RC && d >= 64) {
                const int t = (row - RC) & 4095, pi0 = (d - 64) >> 1;
                const int pos = pi0 < 8 ? (t >> 6) : (t & 63);
                const float* ct = (const float*)(ws + WS_ROPE) + pos * 8 + (pi0 & 7); const float* stb = ct + 512;
                const f32x4 c = *(const f32x4*)ct, s = *(const f32x4*)stb;
                f32x4 a, b;
                a[0] = v0[0] * c[0] - v0[1] * s[0]; a[1] = v0[0] * s[0] + v0[1] * c[0];
                a[2] = v0[2] * c[1] - v0[3] * s[1]; a[3] = v0[2] * s[1] + v0[3] * c[1];
                b[0] = v1[0] * c[2] - v1[1] * s[2]; b[1] = v1[0] * s[2] + v1[1] * c[2];
                b[2] = v1[2] * c[3] - v1[3] * s[3]; b[3] = v1[2] * s[3] + v1[3] * c[3];
                v0 = a; v1 = b;
            }
            st8bf((bf16_t*)out + (size_t)row * 768 + col, v0 * sc, v1 * sc);
        } break;
        case EM_BF16: st8bf((bf16_t*)out + (size_t)row * ldc + col, v0, v1); break;
        case EM_G1: {
            const u32x4 g = *(const u32x4*)((const bf16_t*)(ws + WS_MG) + (size_t)row * 2048 + col);
            f32x4 a, b; a[0] = v0[0] * bflo(g.x); a[1] = v0[1] * bfhi(g.x); a[2] = v0[2] * bflo(g.y); a[3] = v0[3] * bfhi(g.y);
            b[0] = v1[0] * bflo(g.z); b[1] = v1[1] * bfhi(g.z); b[2] = v1[2] * bflo(g.w); b[3] = v1[3] * bfhi(g.w);
            st8bf((bf16_t*)out + (size_t)row * 1024 + col, a, b);
        } break;
        case EM_G2: {
            const u32x4 g = *(const u32x4*)((const bf16_t*)(ws + WS_MG) + (size_t)row * 2048 + 1024 + col);
            const u32x4 z = *(const u32x4*)((const bf16_t*)out + (size_t)row * 1024 + col);
            f32x4 a, b; a[0] = bflo(z.x) + v0[0] * bflo(g.x); a[1] = bfhi(z.x) + v0[1] * bfhi(g.x); a[2] = bflo(z.y) + v0[2] * bflo(g.y); a[3] = bfhi(z.y) + v0[3] * bfhi(g.y);
            b[0] = bflo(z.z) + v1[0] * bflo(g.z); b[1] = bfhi(z.z) + v1[1] * bfhi(g.z); b[2] = bflo(z.w) + v1[2] * bflo(g.w); b[3] = bfhi(z.w) + v1[3] * bfhi(g.w);
            st8bf((bf16_t*)out + (size_t)row * 1024 + col, a, b);
        } break;
        case EM_F32: { float* d = (float*)out + (size_t)row * ldc + col; *(f32x4*)d = v0; *(f32x4*)(d + 4) = v1; } break;
        case EM_RELU2: {
#pragma unroll
            for (int e = 0; e < 4; ++e) { const float a = v0[e] > 0.f ? v0[e] : 0.f, b = v1[e] > 0.f ? v1[e] : 0.f; v0[e] = a * a; v1[e] = b * b; }
            st8bf((bf16_t*)out + (size_t)(col >> 11) * hstride + (size_t)row * 2048 + (col & 2047), v0, v1);
        } break;
        case EM_ADD: {
            bf16_t* d = (bf16_t*)out + (size_t)row * ldc + col; const u32x4 z = *(const u32x4*)d;
            f32x4 a, b; a[0] = bflo(z.x) + v0[0]; a[1] = bfhi(z.x) + v0[1]; a[2] = bflo(z.y) + v0[2]; a[3] = bfhi(z.y) + v0[3];
            b[0] = bflo(z.z) + v1[0]; b[1] = bfhi(z.z) + v1[1]; b[2] = bflo(z.w) + v1[2]; b[3] = bfhi(z.w) + v1[3];
            st8bf(d, a, b);
        } break;
        }
    }
    template <int MODE, int I> DI void step(const f32x4 (&acc)[2][2][4][2], const pg8::Unit& u, int wr, int wc, int fr, int fq) const {
        constexpr int ai = I >> 3, m = (I >> 1) & 3, bj = I & 1;
        one<MODE>(u.pm * 256 + ai * 128 + wr * 64 + m * 16 + fr, u.pn * 256 + bj * 128 + wc * 32 + 8 * fq, u.pn, acc[ai][bj][m][0], acc[ai][bj][m][1]);
    }
    template <int MODE, int... Is> DI void runseq(std::integer_sequence<int, Is...>, const f32x4 (&acc)[2][2][4][2], const pg8::Unit& u, int wr, int wc, int fr, int fq) const {
        (step<MODE, Is>(acc, u, wr, wc, fr, fq), ...);
    }
    template <int MODE> DI void run(const f32x4 (&acc)[2][2][4][2], const pg8::Unit& u, int wr, int wc, int fr, int fq) const {
        runseq<MODE>(std::make_integer_sequence<int, 16>{}, acc, u, wr, wc, fr, fq);
    }
    DI void operator()(const f32x4 (&acc)[2][2][4][2], const pg8::Unit& u, int wr, int wc, int fr, int fq) const {
        switch (mode) {
        case EM_IN: run<EM_IN>(acc, u, wr, wc, fr, fq); break;
        case EM_Q: run<EM_Q>(acc, u, wr, wc, fr, fq); break;
        case EM_BF16: run<EM_BF16>(acc, u, wr, wc, fr, fq); break;
        case EM_G1: run<EM_G1>(acc, u, wr, wc, fr, fq); break;
        case EM_G2: run<EM_G2>(acc, u, wr, wc, fr, fq); break;
        case EM_F32: run<EM_F32>(acc, u, wr, wc, fr, fq); break;
        case EM_ADD: run<EM_ADD>(acc, u, wr, wc, fr, fq); break;
        default: run<EM_RELU2>(acc, u, wr, wc, fr, fq); break;
        }
    }
};

DI int win_src(int n) {
    if (n < 2048) return n;
    if (n < 2432) return n + 16;
    if (n < 2464) return n - 2432 + 2704;
    if (n < 2480) return n - 2464 + 2048;
    if (n < 2560) return -1;
    if (n < 2816) return n - 2560 + 2448;
    return n - 2816 + 2736;
}
DI void transpose_item(const float* __restrict__ W, int K, int Nsrc, bf16_t* WT, int nblk, int mode, float* scr, int item, int lane) {
    const int kb = item / nblk, nb = item % nblk, k0 = 64 * kb, n0 = 32 * nb;
    const int nd = n0 + (lane & 31);
    int src = nd;
    if (mode == 1) src = win_src(nd); else if (mode == 2) src = (nd >> 6) * 128 + (nd & 63); else if (mode == 3) src = (nd >> 6) * 128 + 64 + (nd & 63);
#pragma unroll 8
    for (int i = 0; i < 32; ++i) { const int kk = 2 * i + (lane >> 5); scr[kk * 33 + (lane & 31)] = src >= 0 ? W[(size_t)(k0 + kk) * Nsrc + src] : 0.f; }
    asm volatile("s_waitcnt lgkmcnt(0)" ::: "memory"); asm volatile("" ::: "memory");
    const int c = lane & 7;
#pragma unroll
    for (int j = 0; j < 4; ++j) { const int n = (lane >> 3) + 8 * j; const float* s = scr + (8 * c) * 33 + n;
        u32x4 o; o.x = pk2(s[0 * 33], s[1 * 33]); o.y = pk2(s[2 * 33], s[3 * 33]); o.z = pk2(s[4 * 33], s[5 * 33]); o.w = pk2(s[6 * 33], s[7 * 33]);
        *(u32x4*)(WT + (size_t)(n0 + n) * K + k0 + 8 * c) = o; }
    asm volatile("s_waitcnt lgkmcnt(0)" ::: "memory"); asm volatile("" ::: "memory");
}
DI void phase_A(const Params& p, unsigned char* lds, const bool late) {
    const int tid = tid_(), lane = tid & 63, wave = tid >> 6;
    unsigned char* ws = lp_(p.ws);
    if (late) { }
    else if (bid_() < 192) {
        float* red = (float*)lds;
        float* sl = (float*)lds + 16 * 5 * 32;
        const float* wa = p.in[9]; const float* cl = p.in[7]; const float* cc = p.in[8];
        for (int e = tid; e < 5 * 1024; e += NT) { const float c = e < 1024 ? cc[e] : cl[e - 1024]; sl[e] = c * sigmoidf_(c); }
        __syncthreads();
        const int col = tid & 31, kg = tid >> 5, n0 = bid_() * 32;
        float acc[5] = {0.f, 0.f, 0.f, 0.f, 0.f};
        for (int k0 = kg; k0 < 1024; k0 += 16 * 8) {
            float w[8];
#pragma unroll
            for (int q = 0; q < 8; ++q) w[q] = wa[(size_t)(k0 + 16 * q) * 6144 + n0 + col];
#pragma unroll
            for (int q = 0; q < 8; ++q)
#pragma unroll
                for (int v = 0; v < 5; ++v) acc[v] += sl[v * 1024 + k0 + 16 * q] * w[q];
        }
#pragma unroll
        for (int v = 0; v < 5; ++v) red[(kg * 5 + v) * 32 + col] = acc[v];
        __syncthreads();
        if (tid < 160) { const int v = tid >> 5, c = tid & 31; float s = 0.f;
            for (int g = 0; g < 16; ++g) s += red[(g * 5 + v) * 32 + c];
            __hip_atomic_store((float*)(ws + WS_MOD) + v * 6144 + n0 + c, s + p.in[10][n0 + c], __ATOMIC_RELAXED, __HIP_MEMORY_SCOPE_AGENT); }
        asm volatile("s_waitcnt vmcnt(0)" ::: "memory");
        __syncthreads();
        if (tid == 0) __hip_atomic_fetch_add((unsigned*)(ws + WS_ADACNT), 1u, __ATOMIC_RELAXED, __HIP_MEMORY_SCOPE_AGENT);
    } else if (bid_() == 255) {
        const int pos = tid >> 3, j = tid & 7;
        double inv = 1.0; for (int i = 0; i < j; ++i) inv *= 0.31622776601683794;
        const double x = (double)pos * inv;
        const double kq = rint(x * 0.6366197723675814); const double r = x - kq * 1.5707963267948966, r2 = r * r;
        const double sn = r * (1.0 + r2 * (-1.0 / 6 + r2 * (1.0 / 120 + r2 * (-1.0 / 5040 + r2 * (1.0 / 362880 + r2 * (-1.0 / 39916800 + r2 * (1.0 / 6227020800.0)))))));
        const double cs = 1.0 + r2 * (-0.5 + r2 * (1.0 / 24 + r2 * (-1.0 / 720 + r2 * (1.0 / 40320 + r2 * (-1.0 / 3628800 + r2 * (1.0 / 479001600.0))))));
        const int q = ((int)kq) & 3;
        const double cv = q == 0 ? cs : (q == 1 ? -sn : (q == 2 ? -cs : sn));
        const double sv = q == 0 ? sn : (q == 1 ? cs : (q == 2 ? -sn : -cs));
        float* T = (float*)(ws + WS_ROPE); T[pos * 8 + j] = (float)cv; T[512 + pos * 8 + j] = (float)sv;
    }
    float* scr = (float*)lds + wave * (64 * 33);
    const int gw = bid_() * 8 + wave, NGW = gridDim.x * 8;
    constexpr int I0 = 16 * 152, I1 = 6 * 24, I2 = 4 * 16, I3 = 4 * 16, I4 = 8 * 32, I5 = 8 * 32, I6 = 16 * 32, I7 = 16 * 128, I8 = 64 * 32;
    constexpr int NITEMS = I0 + I1 + I2 + I3 + I4 + I5 + I6 + I7 + I8;
    for (int it = late ? I0 + gw : gw; it < (late ? NITEMS : I0); it += NGW) {
        int r = it;
        if (r < I0) { transpose_item(p.in[15], 1024, 4784, (bf16_t*)(ws + WS_WIN), 152, 1, scr, r, lane); continue; } r -= I0;
        if (r < I1) { transpose_item(p.in[19], 384, 768, (bf16_t*)(ws + WS_WUQ), 24, 0, scr, r, lane); continue; } r -= I1;
        if (r < I2) { transpose_item(p.in[20], 256, 1024, (bf16_t*)(ws + WS_WUK), 16, 2, scr, r, lane); continue; } r -= I2;
        if (r < I3) { transpose_item(p.in[20], 256, 1024, (bf16_t*)(ws + WS_WV), 16, 3, scr, r, lane); continue; } r -= I3;
        if (r < I4) { transpose_item(p.in[21], 512, 1024, (bf16_t*)(ws + WS_WOA), 32, 0, scr, r, lane); continue; } r -= I4;
        if (r < I5) { transpose_item(p.in[23], 512, 1024, (bf16_t*)(ws + WS_WOM), 32, 0, scr, r, lane); continue; } r -= I5;
        if (r < I6) { transpose_item(p.in[24], 1024, 1024, (bf16_t*)(ws + WS_WOUT), 32, 0, scr, r, lane); continue; } r -= I6;
        if (r < I7) { transpose_item(p.in[25], 1024, 4096, (bf16_t*)(ws + WS_W1), 128, 0, scr, r, lane); continue; } r -= I7;
        if (r < 1024) transpose_item(p.in[26], 2048, 1024, (bf16_t*)(ws + WS_W2), 32, 0, scr, r, lane);
        else transpose_item(p.in[26] + (size_t)2048 * 1024, 2048, 1024, (bf16_t*)(ws + WS_W2) + (size_t)1024 * 2048, 32, 0, scr, r - 1024, lane);
    }
}

DI const float* xrow_ptr(const Params& p, int row) { return row < RC ? p.in[0] + (size_t)row * DM : p.in[1] + (size_t)(row - RC) * DM; }
DI int row_group(int row) { return row < RC ? 0 : 1 + ((row - RC) >> 12); }
DI float ssq4(const f32x4& v) { return (v.x * v.x + v.y * v.y) + (v.z * v.z + v.w * v.w); }
DI void phase_B(const Params& p) {
    constexpr int NR = 4;
    {
        if (tid_() == 0) { unsigned* c = (unsigned*)(lp_(p.ws) + WS_ADACNT); while (__hip_atomic_load(c, __ATOMIC_RELAXED, __HIP_MEMORY_SCOPE_AGENT) < 192u) __builtin_amdgcn_s_sleep(2);
            __builtin_amdgcn_fence(__ATOMIC_ACQUIRE, "agent"); asm volatile("s_waitcnt vmcnt(0)" ::: "memory"); }
        __syncthreads();
    }
    const int lane = tid_() & 63, gw = bid_() * 8 + (tid_() >> 6), NGW = gridDim.x * 8;
    const float* mod = (const float*)(lp_(p.ws) + WS_MOD); const float* nw = p.in[11];
    bf16_t* H1 = (bf16_t*)((unsigned char*)p.out + DO_H1);
    for (int row0 = gw * NR; row0 < R; row0 += NGW * NR) {
        f32x4 v[NR][4]; float s[NR];
#pragma unroll
        for (int r = 0; r < NR; ++r) { const f32x4* xr = (const f32x4*)xrow_ptr(p, row0 + r) + lane;
#pragma unroll
            for (int j = 0; j < 4; ++j) v[r][j] = xr[64 * j]; }
#pragma unroll
        for (int r = 0; r < NR; ++r) { s[r] = 0.f;
#pragma unroll
            for (int j = 0; j < 4; ++j) s[r] += ssq4(v[r][j]);
            s[r] = rsqrtf(wave_sum(s[r]) * (1.f / DM) + 1e-6f); }
        const float* mv = mod + row_group(row0) * 6144;
#pragma unroll
        for (int j = 0; j < 4; ++j) { const int c = 4 * lane + 256 * j;
            const f32x4 w = *(const f32x4*)(nw + c), sh = *(const f32x4*)(mv + c), sc = *(const f32x4*)(mv + 1024 + c);
#pragma unroll
            for (int r = 0; r < NR; ++r) { const f32x4 h = v[r][j] * s[r] * w * (sc + 1.f) + sh;
                u32x2 o; o.x = pk2(h.x, h.y); o.y = pk2(h.z, h.w); *(u32x2*)(H1 + (size_t)(row0 + r) * DM + c) = o; } }
    }
}
DI void phase_I(const Params& p) {
    constexpr int NR = 4;
    const int lane = tid_() & 63, gw = bid_() * 8 + (tid_() >> 6), NGW = gridDim.x * 8;
    const float* mod = (const float*)(lp_(p.ws) + WS_MOD); const float* post1 = p.in[12]; const float* pre2 = p.in[13];
    const bf16_t* MIX = (const bf16_t*)(p.ws + WS_MG); bf16_t* H2 = (bf16_t*)(p.ws + WS_H2);
    for (int row0 = gw * NR; row0 < R; row0 += NGW * NR) {
        f32x4 x[NR][4], m[NR][4]; float rs[NR], rstd[NR];
#pragma unroll
        for (int r = 0; r < NR; ++r) { const f32x4* xr = (const f32x4*)xrow_ptr(p, row0 + r) + lane; const u32x2* mr = (const u32x2*)(MIX + (size_t)(row0 + r) * DM) + lane;
#pragma unroll
            for (int j = 0; j < 4; ++j) { x[r][j] = xr[64 * j]; const u32x2 mm = mr[64 * j]; m[r][j].x = bflo(mm.x); m[r][j].y = bfhi(mm.x); m[r][j].z = bflo(mm.y); m[r][j].w = bfhi(mm.y); } }
#pragma unroll
        for (int r = 0; r < NR; ++r) { float s = 0.f;
#pragma unroll
            for (int j = 0; j < 4; ++j) s += ssq4(m[r][j]);
            rs[r] = rsqrtf(wave_sum(s) * (1.f / DM) + 1e-6f); }
        const float* mv = mod + row_group(row0) * 6144;
#pragma unroll
        for (int r = 0; r < NR; ++r) rstd[r] = 0.f;
#pragma unroll
        for (int j = 0; j < 4; ++j) { const int c = 4 * lane + 256 * j;
            const f32x4 w = *(const f32x4*)(post1 + c), g = *(const f32x4*)(mv + 2048 + c);
#pragma unroll
            for (int r = 0; r < NR; ++r) { x[r][j] = x[r][j] + g * (m[r][j] * rs[r] * w);
                *(f32x4*)(p.out + (size_t)(row0 + r) * DM + c) = x[r][j]; rstd[r] += ssq4(x[r][j]); } }
#pragma unroll
        for (int r = 0; r < NR; ++r) rstd[r] = rsqrtf(wave_sum(rstd[r]) * (1.f / DM) + 1e-6f);
#pragma unroll
        for (int j = 0; j < 4; ++j) { const int c = 4 * lane + 256 * j;
            const f32x4 w = *(const f32x4*)(pre2 + c), sh = *(const f32x4*)(mv + 3072 + c), sc = *(const f32x4*)(mv + 4096 + c);
#pragma unroll
            for (int r = 0; r < NR; ++r) { const f32x4 h = x[r][j] * rstd[r] * w * (sc + 1.f) + sh;
                u32x2 o; o.x = pk2(h.x, h.y); o.y = pk2(h.z, h.w); *(u32x2*)(H2 + (size_t)(row0 + r) * DM + c) = o; } }
    }
}
DI void phase_L(const Params& p, int row_start, int nrows, const bf16_t* F0, const bf16_t* F1, bool dry = false) {
    constexpr int NR = 4;
    const int lane = tid_() & 63, gw = bid_() * 8 + (tid_() >> 6), NGW = gridDim.x * 8;
    const float* mod = (const float*)(lp_(p.ws) + WS_MOD); const float* post2 = p.in[14];
    for (int rl0 = gw * NR; rl0 < nrows; rl0 += NGW * NR) {
        f32x4 f[NR][4], y[NR][4]; float rs[NR];
#pragma unroll
        for (int r = 0; r < NR; ++r) { const u32x2* fr = (const u32x2*)(F0 + (size_t)(rl0 + r) * DM) + lane; const f32x4* yr = (const f32x4*)(p.out + (size_t)(row_start + rl0 + r) * DM) + lane;
#pragma unroll
            for (int j = 0; j < 4; ++j) { const u32x2 ff = fr[64 * j]; f[r][j].x = bflo(ff.x); f[r][j].y = bfhi(ff.x); f[r][j].z = bflo(ff.y); f[r][j].w = bfhi(ff.y); y[r][j] = yr[64 * j]; }
            if (F1) { const u32x2* gr = (const u32x2*)(F1 + (size_t)(rl0 + r) * DM) + lane;
#pragma unroll
                for (int j = 0; j < 4; ++j) { const u32x2 ff = gr[64 * j]; f[r][j].x += bflo(ff.x); f[r][j].y += bfhi(ff.x); f[r][j].z += bflo(ff.y); f[r][j].w += bfhi(ff.y); } } }
#pragma unroll
        for (int r = 0; r < NR; ++r) { float s = 0.f;
#pragma unroll
            for (int j = 0; j < 4; ++j) s += ssq4(f[r][j]);
            rs[r] = rsqrtf(wave_sum(s) * (1.f / DM) + 1e-6f); }
        const float* mv = mod + row_group(row_start + rl0) * 6144;
#pragma unroll
        for (int j = 0; j < 4; ++j) { const int c = 4 * lane + 256 * j;
            const f32x4 w = *(const f32x4*)(post2 + c), g = *(const f32x4*)(mv + 5120 + c);
#pragma unroll
            for (int r = 0; r < NR; ++r) if (!dry || rs[r] == 12345.678f) *(f32x4*)(p.out + (size_t)(row_start + rl0 + r) * DM + c) = y[r][j] + g * (f[r][j] * rs[r] * w); }
    }
}
DI int key_row(int row) { return row < RC ? row : RC + ((row - RC) >> 12) * 4608 + ((row - RC) & 4095); }
DI void phase_D(const Params& p) {
    constexpr int NR = 4;
    const int tid = tid_(), lane = tid & 63, gw = bid_() * 8 + (tid >> 6), NGW = gridDim.x * 8, gt = bid_() * NT + tid, NGT = gridDim.x * NT;
    unsigned char* ws = lp_(p.ws); unsigned char* dob = (unsigned char*)p.out;
    bf16_t* CQ = (bf16_t*)(ws + WS_CQ); const bf16_t* CKV = (const bf16_t*)(dob + DO_CKV); const float* KRR = (const float*)(ws + WS_KRRAW);
    bf16_t* KC = (bf16_t*)(dob + DO_KC); bf16_t* KR = (bf16_t*)(ws + WS_KR); const float* RT = (const float*)(ws + WS_ROPE);
    const float* qn = p.in[17]; const float* kvn = p.in[18];
    for (int row0 = gw * NR; row0 < R; row0 += NGW * NR) {
        unsigned u[NR][3]; u32x2 kv[NR];
#pragma unroll
        for (int r = 0; r < NR; ++r) { const unsigned* cq = (const unsigned*)(CQ + (size_t)(row0 + r) * 384);
#pragma unroll
            for (int j = 0; j < 3; ++j) u[r][j] = cq[lane + 64 * j];
            kv[r] = *(const u32x2*)(CKV + (size_t)(row0 + r) * 256 + 4 * lane); }
#pragma unroll
        for (int r = 0; r < NR; ++r) { const int row = row0 + r; float s = 0.f;
#pragma unroll
            for (int j = 0; j < 3; ++j) { const float a = bflo(u[r][j]), b = bfhi(u[r][j]); s += a * a + b * b; }
            const float rq = rsqrtf(wave_sum(s) * (1.f / 384) + 1e-6f);
            unsigned* cq = (unsigned*)(CQ + (size_t)row * 384);
#pragma unroll
            for (int j = 0; j < 3; ++j) { const int c = 2 * (lane + 64 * j); cq[lane + 64 * j] = pk2(bflo(u[r][j]) * rq * qn[c], bfhi(u[r][j]) * rq * qn[c + 1]); }
            f32x4 v; v.x = bflo(kv[r].x); v.y = bfhi(kv[r].x); v.z = bflo(kv[r].y); v.w = bfhi(kv[r].y);
            const float rk = rsqrtf(wave_sum(ssq4(v)) * (1.f / 256) + 1e-6f);
            v = v * rk * *(const f32x4*)(kvn + 4 * lane);
            u32x2 o; o.x = pk2(v.x, v.y); o.y = pk2(v.z, v.w); *(u32x2*)(KC + (size_t)key_row(row) * 256 + 4 * lane) = o;
            if (row < RC) *(f32x4*)(p.out + OUT_CKV + (size_t)row * 256 + 4 * lane) = v; }
    }
    for (int e = gt; e < R * 16; e += NGT) { const int row = e >> 4, pi = e & 15;
        const float x1 = KRR[(size_t)row * 32 + 2 * pi], x2 = KRR[(size_t)row * 32 + 2 * pi + 1]; float o1 = x1, o2 = x2;
        if (row < RC) { p.out[OUT_KROPE + (size_t)row * 32 + 2 * pi] = x1; p.out[OUT_KROPE + (size_t)row * 32 + 2 * pi + 1] = x2; }
        else { const int t = (row - RC) & 4095, pos = pi < 8 ? (t >> 6) : (t & 63); const float c = RT[pos * 8 + (pi & 7)], sn = RT[512 + pos * 8 + (pi & 7)];
            o1 = x1 * c - x2 * sn; o2 = x1 * sn + x2 * c; }
        *(unsigned*)(KR + (size_t)key_row(row) * 32 + 2 * pi) = pk2(o1, o2); }
    for (int e = gt; e < 2048 * 64; e += NGT) { const int j2 = e >> 6, c4 = e & 63, b = j2 >> 9, j = j2 & 511, kr = RC + b * 4608 + 4096 + j;
        const f32x4 v = *(const f32x4*)(p.in[2] + (size_t)j2 * 256 + 4 * c4);
        u32x2 o; o.x = pk2(v.x, v.y); o.y = pk2(v.z, v.w); *(u32x2*)(KC + (size_t)kr * 256 + 4 * c4) = o; }
    for (int e = gt; e < 2048 * 16; e += NGT) { const int j2 = e >> 4, pi = e & 15, b = j2 >> 9, j = j2 & 511, kr = RC + b * 4608 + 4096 + j;
        *(unsigned*)(KR + (size_t)kr * 32 + 2 * pi) = pk2(p.in[3][(size_t)j2 * 32 + 2 * pi], p.in[3][(size_t)j2 * 32 + 2 * pi + 1]); }
}

constexpr int KT_STR = 320;
constexpr int KR_STR = 272;
DI void scan_add2(float x0, float x1, float& b0, float& b1, int lane) {
    float s = x0 + x1;
#pragma unroll
    for (int o = 1; o < 64; o <<= 1) { const float t = __shfl_up(s, o); if (lane >= o) s += t; }
    b1 = s; b0 = s - x1;
}
DI void scan_max2(float x0, float x1, float& m0, float& m1, int lane) {
    float s = fmaxf(x0, x1);
#pragma unroll
    for (int o = 1; o < 64; o <<= 1) { const float t = __shfl_up(s, o); if (lane >= o) s = fmaxf(s, t); }
    m1 = s; const float prev = __shfl_up(s, 1); m0 = lane > 0 ? fmaxf(prev, x0) : x0;
}
DI int tr_off(int lane, int r0, int c0) { const int i = lane & 15; return (r0 + (i >> 2)) * KT_STR + (c0 + 4 * (i & 3)) * 2; }

DI void phase_M1(const Params& p, unsigned char* lds) {
    const int tid = tid_(), lane = tid & 63, wave = tid >> 6, hh = lane >> 5, g1 = (lane >> 4) & 1;
    unsigned char* ws = lp_(p.ws);
    const bf16_t* MQKV = (const bf16_t*)(ws + WS_MQKV); const float* GATES = (const float*)(ws + WS_GATES);
    bf16_t* SLOT = (bf16_t*)((unsigned char*)p.out + DO_SLOT); float* NST = (float*)(ws + WS_NST); float* SC = (float*)(ws + WS_SC);
    unsigned char* Kt = lds; unsigned char* Vt = lds + 128 * KT_STR; float* wbuf = (float*)(lds + 2 * 128 * KT_STR);
    const LAS char* Kt3 = (const LAS char*)Kt; const LAS char* Vt3 = (const LAS char*)Vt;
#define M1_DECODE(u_, slot_, rowbase_, h_, d_) do { \
        if ((u_) < 512) { const int c = (u_) >> 1, k = (u_) & 1; d_ = c & 1; h_ = (c >> 1) & 3; const int s = c >> 3; rowbase_ = s * 256 + (d_ ? 1 - k : k) * 128; slot_ = 2 * c + k; } \
        else { const int v = (u_) - 512, lc = v / 31, k = v % 31; d_ = lc & 1; h_ = (lc >> 1) & 3; const int b = lc >> 3; rowbase_ = RC + b * 4096 + (d_ ? 31 - k : k) * 128; slot_ = 512 + 32 * lc + k + 1; } } while (0)
#define M1_LOAD(rowbase_, h_, d_) do { \
        _Pragma("unroll") for (int i = 0; i < 4; ++i) { const int id = tid + NT * i, row = id >> 4, ch = id & 15; \
            const bf16_t* src = MQKV + (size_t)((rowbase_) + row) * 1536 + (h_) * 128 + ch * 8; rk[i] = *(const u32x4*)(src + 512); rv[i] = *(const u32x4*)(src + 1024); } \
        if (wave == 0) { const int p0 = 2 * lane, p1 = p0 + 1, t0 = (d_) ? 127 - p0 : p0, t1 = (d_) ? 127 - p1 : p1; \
            gf0 = GATES[(size_t)((rowbase_) + t0) * 16 + (d_) * 8 + 4 + (h_)]; gf1 = GATES[(size_t)((rowbase_) + t1) * 16 + (d_) * 8 + 4 + (h_)]; \
            gi0 = GATES[(size_t)((rowbase_) + t0) * 16 + (d_) * 8 + (h_)]; gi1 = GATES[(size_t)((rowbase_) + t1) * 16 + (d_) * 8 + (h_)]; } } while (0)
    u32x4 rk[4], rv[4]; float gf0 = 0.f, gf1 = 0.f, gi0 = 0.f, gi1 = 0.f;
    int slot = 0, rowbase = 0, h = 0, d = 0;
    if (bid_() < 1504) { M1_DECODE(bid_(), slot, rowbase, h, d); M1_LOAD(rowbase, h, d); }
    for (int u = bid_(); u < 1504; u += gridDim.x) {
        if (wave == 0) {
            const int p0 = 2 * lane, p1 = p0 + 1, t0 = d ? 127 - p0 : p0, t1 = d ? 127 - p1 : p1;
            float b0, b1; scan_add2(gf0, gf1, b0, b1, lane);
            const float bL = __shfl(b1, 63);
            const float ga = bL - b0 + gi0, gb = bL - b1 + gi1, ml = wave_max(fmaxf(ga, gb));
            wbuf[t0] = __expf(ga - ml); wbuf[t1] = __expf(gb - ml);
            if (lane == 0) { SC[slot * 2] = bL; SC[slot * 2 + 1] = ml; }
        }
        __syncthreads();
#pragma unroll
        for (int i = 0; i < 4; ++i) { const int id = tid + NT * i, row = id >> 4, ch = id & 15;
            const u32x4 kv = rk[i]; const float w = wbuf[row];
            u32x4 ko; ko.x = pk2(bflo(kv.x) * w, bfhi(kv.x) * w); ko.y = pk2(bflo(kv.y) * w, bfhi(kv.y) * w); ko.z = pk2(bflo(kv.z) * w, bfhi(kv.z) * w); ko.w = pk2(bflo(kv.w) * w, bfhi(kv.w) * w);
            *(u32x4*)(Kt + row * KT_STR + ch * 16) = ko; *(u32x4*)(Vt + row * KT_STR + ch * 16) = rv[i]; }
        __syncthreads();
        const int cslot = slot;
        { const int un = u + gridDim.x; if (un < 1504) { M1_DECODE(un, slot, rowbase, h, d); M1_LOAD(rowbase, h, d); } }
        const int dvb = wave >> 1, dk0 = 2 * (wave & 1);
        f32x16 acc[2], accn[2];
#pragma unroll
        for (int e = 0; e < 16; ++e) { acc[0][e] = 0.f; acc[1][e] = 0.f; accn[0][e] = 0.f; accn[1][e] = 0.f; }
        bf16x8 ones;
#pragma unroll
        for (int e = 0; e < 8; ++e) ones[e] = (short)0x3f80;
#pragma unroll
        for (int ks = 0; ks < 8; ++ks) {
            const int r0 = 16 * ks + 8 * hh;
            const bf16x8 a = cat4(tr_read(Vt3 + tr_off(lane, r0, dvb * 32 + 16 * g1)), tr_read(Vt3 + tr_off(lane, r0 + 4, dvb * 32 + 16 * g1)));
#pragma unroll
            for (int j = 0; j < 2; ++j) {
                const bf16x8 b = cat4(tr_read(Kt3 + tr_off(lane, r0, (dk0 + j) * 32 + 16 * g1)), tr_read(Kt3 + tr_off(lane, r0 + 4, (dk0 + j) * 32 + 16 * g1)));
                acc[j] = MFMA32(a, b, acc[j]);
                if (dvb == 0) accn[j] = MFMA32(ones, b, accn[j]);
            }
        }
        bf16_t* so = SLOT + (size_t)cslot * 16384;
#pragma unroll
        for (int j = 0; j < 2; ++j)
#pragma unroll
            for (int e = 0; e < 16; ++e) so[(dvb * 32 + crow(e, hh)) * 128 + (dk0 + j) * 32 + (lane & 31)] = (bf16_t)(pk2(acc[j][e], 0.f) & 0xffffu);
        if (dvb == 0 && hh == 0) { NST[(size_t)cslot * 128 + dk0 * 32 + lane] = accn[0][0]; NST[(size_t)cslot * 128 + (dk0 + 1) * 32 + lane] = accn[1][0]; }
        __syncthreads();
    }
}

DI void phase_M2(const Params& p, unsigned char* lds) {
    const int gt = bid_() * NT + tid_();
    unsigned char* ws = lp_(p.ws);
    bf16_t* SLOT = (bf16_t*)((unsigned char*)p.out + DO_SLOT); float* NST = (float*)(ws + WS_NST); const float* SC = (const float*)(ws + WS_SC); float* MP = (float*)(ws + WS_MP);
    if (gt < 65536) {
        const int lc = gt >> 11, v = gt & 2047, dv = v >> 4, dko = v & 15, d = lc & 1, h = (lc >> 1) & 3, b = lc >> 3;
        const float* C0 = p.in[4] + (size_t)((b * 2 + d) * 4 + h) * 16384;
        float C[8];
#pragma unroll
        for (int j = 0; j < 8; ++j) C[j] = C0[(dko * 8 + j) * 128 + dv];
        float m = p.in[6][(b * 2 + d) * 4 + h];
        const int s0 = 512 + 32 * lc;
        { u32x4 o; o.x = pk2(C[0], C[1]); o.y = pk2(C[2], C[3]); o.z = pk2(C[4], C[5]); o.w = pk2(C[6], C[7]); *(u32x4*)(SLOT + (size_t)s0 * 16384 + v * 8) = o; }
        float nv[8];
        const bool isn = v < 16;
        if (isn) {
#pragma unroll
            for (int j = 0; j < 8; ++j) { nv[j] = p.in[5][((b * 2 + d) * 4 + h) * 128 + v * 8 + j]; NST[(size_t)s0 * 128 + v * 8 + j] = nv[j]; }
        }
        if (v == 0) MP[s0] = m;
        for (int k0 = 0; k0 < 31; k0 += 4) {
            u32x4 uu[4]; float bLs[4], mls[4]; float nu[4][8];
#pragma unroll
            for (int q = 0; q < 4; ++q) if (k0 + q < 31) { const int sl = s0 + k0 + q + 1;
                uu[q] = *(const u32x4*)(SLOT + (size_t)sl * 16384 + v * 8); bLs[q] = SC[sl * 2]; mls[q] = SC[sl * 2 + 1];
                if (isn) {
#pragma unroll
                    for (int jj = 0; jj < 8; ++jj) nu[q][jj] = NST[(size_t)sl * 128 + v * 8 + jj]; } }
#pragma unroll
            for (int q = 0; q < 4; ++q) if (k0 + q < 31) { const int sl = s0 + k0 + q + 1;
                const float bL = bLs[q], ml = mls[q];
                const float mn = fmaxf(bL + m, ml), dec = __expf(bL + m - mn), su = __expf(ml - mn);
                C[0] = dec * C[0] + su * bflo(uu[q].x); C[1] = dec * C[1] + su * bfhi(uu[q].x); C[2] = dec * C[2] + su * bflo(uu[q].y); C[3] = dec * C[3] + su * bfhi(uu[q].y);
                C[4] = dec * C[4] + su * bflo(uu[q].z); C[5] = dec * C[5] + su * bfhi(uu[q].z); C[6] = dec * C[6] + su * bflo(uu[q].w); C[7] = dec * C[7] + su * bfhi(uu[q].w);
                u32x4 o; o.x = pk2(C[0], C[1]); o.y = pk2(C[2], C[3]); o.z = pk2(C[4], C[5]); o.w = pk2(C[6], C[7]); *(u32x4*)(SLOT + (size_t)sl * 16384 + v * 8) = o;
                if (isn) {
#pragma unroll
                    for (int jj = 0; jj < 8; ++jj) { nv[jj] = dec * nv[jj] + su * nu[q][jj]; NST[(size_t)sl * 128 + v * 8 + jj] = nv[jj]; } }
                if (v == 0) MP[sl] = mn;
                m = mn; }
        }
    }
    if (bid_() < 128) {
        const int tid = tid_();
        float* T = (float*)lds;
        for (int c = bid_(); c < 256; c += 128) {
            const int d = c & 1, h = (c >> 1) & 3, s = c >> 3;
            const float bL1 = SC[(2 * c + 1) * 2], ml1 = SC[(2 * c + 1) * 2 + 1], ml0 = SC[(2 * c) * 2 + 1];
            const float m1 = ml0;
            const float m2 = fmaxf(bL1 + m1, ml1), dec = __expf(bL1 + m1 - m2), su = __expf(ml1 - m2);
            u32x4 u0[4], u1[4];
#pragma unroll
            for (int q = 0; q < 4; ++q) { const int v = tid + NT * q;
                u0[q] = *(const u32x4*)(SLOT + (size_t)(2 * c) * 16384 + v * 8); u1[q] = *(const u32x4*)(SLOT + (size_t)(2 * c + 1) * 16384 + v * 8); }
#pragma unroll
            for (int q = 0; q < 4; ++q) { const int v = tid + NT * q, dv = v >> 4, dk0 = (v & 15) * 8;
                T[(dk0 + 0) * 129 + dv] = dec * bflo(u0[q].x) + su * bflo(u1[q].x); T[(dk0 + 1) * 129 + dv] = dec * bfhi(u0[q].x) + su * bfhi(u1[q].x);
                T[(dk0 + 2) * 129 + dv] = dec * bflo(u0[q].y) + su * bflo(u1[q].y); T[(dk0 + 3) * 129 + dv] = dec * bfhi(u0[q].y) + su * bfhi(u1[q].y);
                T[(dk0 + 4) * 129 + dv] = dec * bflo(u0[q].z) + su * bflo(u1[q].z); T[(dk0 + 5) * 129 + dv] = dec * bfhi(u0[q].z) + su * bfhi(u1[q].z);
                T[(dk0 + 6) * 129 + dv] = dec * bflo(u0[q].w) + su * bflo(u1[q].w); T[(dk0 + 7) * 129 + dv] = dec * bfhi(u0[q].w) + su * bfhi(u1[q].w); }
            __syncthreads();
            float* oc = p.out + OUT_C + (size_t)((s * 2 + d) * 4 + h) * 16384;
#pragma unroll
            for (int q = 0; q < 8; ++q) { const int e = tid + NT * q, dk = e >> 5, dv4 = (e & 31) * 4;
                f32x4 o; o.x = T[dk * 129 + dv4]; o.y = T[dk * 129 + dv4 + 1]; o.z = T[dk * 129 + dv4 + 2]; o.w = T[dk * 129 + dv4 + 3];
                *(f32x4*)(oc + dk * 128 + dv4) = o; }
            if (tid < 128) {
                p.out[OUT_N + ((s * 2 + d) * 4 + h) * 128 + tid] = dec * NST[(size_t)(2 * c) * 128 + tid] + su * NST[(size_t)(2 * c + 1) * 128 + tid];
                if (tid == 0) { p.out[OUT_M + (s * 2 + d) * 4 + h] = m2; MP[2 * c] = m1; }
            }
            __syncthreads();
        }
    }
}

DI void phase_M3(const Params& p, unsigned char* lds, bool dry, const int u_first, const int u_end, const int u_step) {
    const int tid = tid_(), lane = tid & 63, wave = tid >> 6, hh = lane >> 5, g1 = (lane >> 4) & 1, l31 = lane & 31;
    unsigned char* ws = lp_(p.ws);
    const bf16_t* MQKV = (const bf16_t*)(ws + WS_MQKV); const float* GATES = (const float*)(ws + WS_GATES);
    const bf16_t* SLOT = (const bf16_t*)((unsigned char*)p.out + DO_SLOT); const float* NST = (const float*)(ws + WS_NST); const float* MP = (const float*)(ws + WS_MP);
    bf16_t* MO = (bf16_t*)(ws + WS_MO); const float* hn = p.in[22]; const float* SCm = (const float*)(ws + WS_SC);
    unsigned char* Kt = lds; unsigned char* Vt = lds + 128 * KR_STR;
    float* X = (float*)lds;
    float* ga = (float*)(lds + 128 * KR_STR + 128 * KT_STR);
    float* gc = ga + 256; float* gb = gc + 256; float* gn = gb + 256;
    const LAS char* Kt3 = (const LAS char*)Kt; const LAS char* Vt3 = (const LAS char*)Vt;
#define M3_DECODE(u_) do { \
        if ((u_) < 256) { lat = false; oc = (u_) & 1; h = ((u_) >> 1) & 3; const int s_ = (u_) >> 3; nc = 2; rowbase = s_ * 256 + oc * 128; cbase = (s_ * 4 + h) * 2; } \
        else { lat = true; const int v_ = (u_) - 256; oc = v_ & 31; h = (v_ >> 5) & 3; const int b_ = v_ >> 7; nc = 32; rowbase = RC + b_ * 4096 + oc * 128; cbase = (b_ * 4 + h) * 2; } \
        { const int k0_ = oc, k1_ = nc - 1 - oc; sl0 = lat ? 512 + 32 * cbase + k0_ : (k0_ == 1 ? 2 * cbase : -1); sl1 = lat ? 512 + 32 * (cbase + 1) + k1_ : (k1_ == 1 ? 2 * (cbase + 1) : -1); } } while (0)
#define M3_LOAD() do { \
        _Pragma("unroll") for (int i = 0; i < 4; ++i) { const int id = tid + NT * i, row = id >> 4, ch = id & 15; \
            const bf16_t* src = MQKV + (size_t)(rowbase + row) * 1536 + h * 128 + ch * 8; rk[i] = *(const u32x4*)(src + 512); rv[i] = *(const u32x4*)(src + 1024); } \
        if (wave < 2) { const int d_ = wave, sl_ = d_ ? sl1 : sl0; \
            const int p0 = 2 * lane, p1 = p0 + 1, t0 = d_ ? 127 - p0 : p0, t1 = d_ ? 127 - p1 : p1; \
            gf0 = GATES[(size_t)(rowbase + t0) * 16 + d_ * 8 + 4 + h]; gf1 = GATES[(size_t)(rowbase + t1) * 16 + d_ * 8 + 4 + h]; \
            gi0 = GATES[(size_t)(rowbase + t0) * 16 + d_ * 8 + h]; gi1 = GATES[(size_t)(rowbase + t1) * 16 + d_ * 8 + h]; \
            gmp = sl_ >= 0 ? (lat ? MP[sl_] : SCm[sl_ * 2 + 1]) : -1e30f; gn0 = sl_ >= 0 ? NST[(size_t)sl_ * 128 + lane] : 0.f; gn1 = sl_ >= 0 ? NST[(size_t)sl_ * 128 + 64 + lane] : 0.f; } } while (0)
    int rowbase = 0, h = 0, oc = 0, nc = 2, cbase = 0, sl0 = -1, sl1 = -1; bool lat = false;
    u32x4 rk[4], rv[4]; float gf0 = 0.f, gf1 = 0.f, gi0 = 0.f, gi1 = 0.f, gmp = 0.f, gn0 = 0.f, gn1 = 0.f;
    if (u_first >= 0 && u_first < u_end) { M3_DECODE(u_first); M3_LOAD(); }
    for (int u = u_first; u >= 0 && u < u_end; u += u_step) {
        if (wave < 2) {
            const int d = wave;
            const int p0 = 2 * lane, p1 = p0 + 1, t0 = d ? 127 - p0 : p0, t1 = d ? 127 - p1 : p1;
            float b0, b1; scan_add2(gf0, gf1, b0, b1, lane);
            const float a0 = gi0 - b0, a1 = gi1 - b1; float m0, m1; scan_max2(a0, a1, m0, m1, lane);
            ga[d * 128 + t0] = a0; ga[d * 128 + t1] = a1; gc[d * 128 + t0] = fmaxf(gmp, m0); gc[d * 128 + t1] = fmaxf(gmp, m1); gb[d * 128 + t0] = b0; gb[d * 128 + t1] = b1;
            gn[d * 128 + lane] = gn0; gn[d * 128 + 64 + lane] = gn1;
        }
#pragma unroll
        for (int i = 0; i < 4; ++i) { const int id = tid + NT * i, row = id >> 4, ch = id & 15;
            *(u32x4*)(Kt + row * KR_STR + ch * 16) = rk[i]; *(u32x4*)(Vt + row * KT_STR + ch * 16) = rv[i]; }
        __syncthreads();
        const int c_rowbase = rowbase, c_h = h;
        const int d = wave >> 2, tb = wave & 3, t = tb * 32 + l31, sl = d ? sl1 : sl0;
        const float mprev = sl >= 0 ? (u < 256 ? SCm[sl * 2 + 1] : MP[sl]) : -1e30f;
        const bf16_t* qrowp = MQKV + (size_t)(c_rowbase + t) * 1536 + c_h * 128 + 8 * hh;
        const float c_t = gc[d * 128 + t], b_t = gb[d * 128 + t];
        const float si = sl >= 0 ? __expf(mprev - c_t) : 0.f;
        float qn = 0.f;
        if (sl >= 0) {
#pragma unroll
            for (int ks = 0; ks < 8; ++ks) { const bf16x8 q = *(const bf16x8*)(qrowp + 16 * ks);
#pragma unroll
                for (int j = 0; j < 8; ++j) qn += bf1((bf16_t)q[j]) * gn[d * 128 + 16 * ks + 8 * hh + j]; }
        }
        qn += __shfl_xor(qn, 32);
        f32x16 H[4];
#pragma unroll
        for (int i = 0; i < 4; ++i)
#pragma unroll
            for (int e = 0; e < 16; ++e) H[i][e] = 0.f;
        float denp = 0.f;
        const int sb_lo = d ? tb : 0, sb_hi = d ? 3 : tb;
#pragma unroll 1
        for (int sb = sb_lo; sb <= sb_hi; ++sb) {
            f32x16 S;
#pragma unroll
            for (int e = 0; e < 16; ++e) S[e] = 0.f;
            const bf16_t* qp = qrowp; asm volatile("" : "+v"(qp));
#pragma unroll
            for (int ks = 0; ks < 8; ++ks) { const bf16x8 a = *(const LAS bf16x8*)(Kt3 + (sb * 32 + l31) * KR_STR + (16 * ks + 8 * hh) * 2); S = MFMA32(a, *(const bf16x8*)(qp + 16 * ks), S); }
#pragma unroll
            for (int e = 0; e < 16; ++e) { const int st = sb * 32 + crow(e, hh); const bool ok = d ? (st >= t) : (st <= t);
                const float w = ok ? __expf(ga[d * 128 + st] - c_t) : 0.f; const float pv = S[e] * w; denp += pv; S[e] = pv; }
            const bf16x8 pb0 = pack8(S, 0), pb1 = pack8(S, 1);
#pragma unroll
            for (int dvb = 0; dvb < 4; ++dvb) {
                const int r0 = sb * 32 + 4 * hh, c0 = dvb * 32 + 16 * g1;
                const bf16x8 a0 = cat4(tr_read(Vt3 + tr_off(lane, r0, c0)), tr_read(Vt3 + tr_off(lane, r0 + 8, c0)));
                const bf16x8 a1 = cat4(tr_read(Vt3 + tr_off(lane, r0 + 16, c0)), tr_read(Vt3 + tr_off(lane, r0 + 24, c0)));
                H[dvb] = MFMA32(a0, pb0, H[dvb]); H[dvb] = MFMA32(a1, pb1, H[dvb]);
            }
        }
        if (sl >= 0) {
            const bf16_t* ct = SLOT + (size_t)sl * 16384;
            const bf16_t* qp2 = qrowp; asm volatile("" : "+v"(qp2));
#pragma unroll
            for (int ks = 0; ks < 8; ++ks) { u32x4 q = *(const u32x4*)(qp2 + 16 * ks);
                q.x = pk2(bflo(q.x) * si, bfhi(q.x) * si); q.y = pk2(bflo(q.y) * si, bfhi(q.y) * si); q.z = pk2(bflo(q.z) * si, bfhi(q.z) * si); q.w = pk2(bflo(q.w) * si, bfhi(q.w) * si);
                const bf16x8 qs = __builtin_bit_cast(bf16x8, q);
#pragma unroll
                for (int dvb = 0; dvb < 4; ++dvb) { const bf16x8 a = *(const bf16x8*)(ct + (dvb * 32 + l31) * 128 + 16 * ks + 8 * hh); H[dvb] = MFMA32(a, qs, H[dvb]); }
            }
        }
        const float den = si * qn + (denp + __shfl_xor(denp, 32));
        const float inv = 1.f / fmaxf(fabsf(den), __expf(-(c_t + b_t)));
#pragma unroll
        for (int i = 0; i < 4; ++i)
#pragma unroll
            for (int e = 0; e < 16; ++e) H[i][e] *= inv;
        __syncthreads();
        { const int un = u + u_step; if (un < u_end) { M3_DECODE(un); M3_LOAD(); } }
        if (d == 1) {
#pragma unroll
            for (int dvb = 0; dvb < 4; ++dvb)
#pragma unroll
                for (int g = 0; g < 4; ++g) { f32x4 v; v.x = H[dvb][4 * g]; v.y = H[dvb][4 * g + 1]; v.z = H[dvb][4 * g + 2]; v.w = H[dvb][4 * g + 3]; *(f32x4*)(X + t * 132 + dvb * 32 + 8 * g + 4 * hh) = v; }
        }
        __syncthreads();
        if (d == 0) {
            float ss = 0.f;
#pragma unroll
            for (int dvb = 0; dvb < 4; ++dvb)
#pragma unroll
                for (int g = 0; g < 4; ++g) { const f32x4 v = *(const f32x4*)(X + t * 132 + dvb * 32 + 8 * g + 4 * hh);
                    H[dvb][4 * g] += v.x; H[dvb][4 * g + 1] += v.y; H[dvb][4 * g + 2] += v.z; H[dvb][4 * g + 3] += v.w;
                    ss += (H[dvb][4 * g] * H[dvb][4 * g] + H[dvb][4 * g + 1] * H[dvb][4 * g + 1]) + (H[dvb][4 * g + 2] * H[dvb][4 * g + 2] + H[dvb][4 * g + 3] * H[dvb][4 * g + 3]); }
            ss += __shfl_xor(ss, 32);
            const float rstd = rsqrtf(ss * (1.f / 128) + 1e-6f);
#pragma unroll
            for (int dvb = 0; dvb < 4; ++dvb)
#pragma unroll
                for (int g = 0; g < 4; ++g) { const int dv = dvb * 32 + 8 * g + 4 * hh; const f32x4 w = *(const f32x4*)(hn + c_h * 128 + dv);
                    u32x2* mp = (u32x2*)(MO + (size_t)(c_rowbase + t) * 512 + c_h * 128 + dv); const u32x2 mo = *mp;
                    u32x2 o; o.x = pk2(H[dvb][4 * g] * rstd * w.x * bflo(mo.x), H[dvb][4 * g + 1] * rstd * w.y * bfhi(mo.x));
                    o.y = pk2(H[dvb][4 * g + 2] * rstd * w.z * bflo(mo.y), H[dvb][4 * g + 3] * rstd * w.w * bfhi(mo.y)); if (!dry || rstd == 12345.678f) *mp = o; }
        }
        __syncthreads();
    }
}

constexpr int AK_STR = 208;
constexpr int AV_STR = 136;
constexpr int A_KB = 64 * AK_STR, A_VB = 64 * AV_STR;
DI float max3f(float a, float b, float c) { float r; asm("v_max3_f32 %0, %1, %2, %3" : "=v"(r) : "v"(a), "v"(b), "v"(c)); return r; }
struct AStage { u32x4 k0, k1, v; };
DI void phase_attn(const Params& p, unsigned char* lds) {
    const int tid = tid_(), lane = tid & 63, wave = tid >> 6, hh = lane >> 5, l31 = lane & 31;
    unsigned char* ws = lp_(p.ws); unsigned char* dob = (unsigned char*)p.out;
    const bf16_t* Q = (const bf16_t*)(ws + WS_Q); const bf16_t* KN = (const bf16_t*)(ws + WS_KN); const bf16_t* KR = (const bf16_t*)(ws + WS_KR);
    const bf16_t* VT = (const bf16_t*)(dob + DO_VT); bf16_t* AO = (bf16_t*)(dob + DO_AO);
    const LAS char* L3 = (const LAS char*)lds;
    const int id1 = (tid + 512) % 768;
    const int kkey0 = tid / 12, kch0 = tid % 12, kkey1 = id1 / 12, kch1 = id1 % 12;
    const int vdv = tid >> 3, vch = tid & 7;
    for (int u = bid_(); u < 768; u += gridDim.x) {
        int qrow0, keybase, nkt, h;
        if (u < 512) {
            const int r = u >> 8, i = u & 255, xcd = i & 7, slot = i >> 3, bh = r * 16 + xcd * 2 + (slot >> 4), qb = slot & 15; h = bh & 7; const int b = bh >> 3;
            qrow0 = RC + b * 4096 + qb * 256; keybase = RC + b * 4608; nkt = 72; }
        else { const int v = u - 512; h = v & 7; const int b = v >> 3; qrow0 = b * 256; keybase = b * 256; nkt = 4; }
        const int qrow = qrow0 + wave * 32 + l31;
        bf16x8 qf[6];
#pragma unroll
        for (int ks = 0; ks < 6; ++ks) qf[ks] = *(const bf16x8*)(Q + (size_t)qrow * 768 + h * 96 + 16 * ks + 8 * hh);
        f32x16 O[2];
#pragma unroll
        for (int e = 0; e < 16; ++e) { O[0][e] = 0.f; O[1][e] = 0.f; }
        const bf16_t* kp0 = kch0 < 8 ? KN + (size_t)(keybase + kkey0) * 512 + h * 64 + kch0 * 8 : KR + (size_t)(keybase + kkey0) * 32 + (kch0 - 8) * 8;
        const bf16_t* kp1 = kch1 < 8 ? KN + (size_t)(keybase + kkey1) * 512 + h * 64 + kch1 * 8 : KR + (size_t)(keybase + kkey1) * 32 + (kch1 - 8) * 8;
        const int ks0 = kch0 < 8 ? 64 * 512 : 64 * 32, ks1 = kch1 < 8 ? 64 * 512 : 64 * 32;
        const bf16_t* vp0 = VT + (size_t)(h * 64 + vdv) * RK + keybase + vch * 8;
#define K_LOAD(st, kt) do { (st).k0 = *(const u32x4*)(kp0 + (size_t)(kt) * ks0); (st).k1 = *(const u32x4*)(kp1 + (size_t)(kt) * ks1); } while (0)
#define V_LOAD(st, kt) do { (st).v = *(const u32x4*)(vp0 + (kt) * 64); } while (0)
#define K_STORE(st, buf) do { unsigned char* b_ = lds + (buf) * A_KB; *(u32x4*)(b_ + kkey0 * AK_STR + kch0 * 16) = (st).k0; *(u32x4*)(b_ + kkey1 * AK_STR + kch1 * 16) = (st).k1; } while (0)
#define V_STORE(st, buf) do { unsigned char* b_ = lds + 2 * A_KB + (buf) * A_VB; u32x2 lo_, hi_; lo_.x = (st).v.x; lo_.y = (st).v.y; hi_.x = (st).v.z; hi_.y = (st).v.w; \
            *(u32x2*)(b_ + vdv * AV_STR + vch * 16) = lo_; *(u32x2*)(b_ + vdv * AV_STR + vch * 16 + 8) = hi_; } while (0)
#define QK_READ(buf) const LAS char* kb3_ = L3 + (buf) * A_KB; bf16x8 ka0[6], ka1[6]; \
            _Pragma("unroll") for (int ks = 0; ks < 6; ++ks) ka0[ks] = *(const LAS bf16x8*)(kb3_ + l31 * AK_STR + (16 * ks + 8 * hh) * 2); \
            _Pragma("unroll") for (int ks = 0; ks < 6; ++ks) ka1[ks] = *(const LAS bf16x8*)(kb3_ + (32 + l31) * AK_STR + (16 * ks + 8 * hh) * 2);
#define FIXUP(Sx, forced) do { \
            float tm = max3f(Sx[0][0], Sx[1][0], Sx[0][1]); \
            _Pragma("unroll") for (int e = 1; e < 15; e += 2) { tm = max3f(tm, Sx[1][e], Sx[0][e + 1]); tm = max3f(tm, Sx[1][e + 1], Sx[0][e + 2]); } \
            tm = fmaxf(tm, Sx[1][15]); tm = fmaxf(tm, __shfl_xor(tm, 32)); \
            if ((forced) || __builtin_amdgcn_ballot_w64(tm > 8.f) != 0ull) { \
                const float delta = (forced) ? tm : fmaxf(tm, 0.f); const float alpha = __builtin_amdgcn_exp2f(-delta); \
                _Pragma("unroll") for (int e = 0; e < 16; ++e) { Sx[0][e] -= delta; Sx[1][e] -= delta; O[0][e] *= alpha; O[1][e] *= alpha; Ol[e] *= alpha; } \
                mbase += delta; } } while (0)
        AStage RA;
        K_LOAD(RA, 0); V_LOAD(RA, 0); K_STORE(RA, 0); V_STORE(RA, 0);
        K_LOAD(RA, 1);
        __syncthreads();
        f32x16 S[2], Ol; float mbase = 0.f;
        bf16x8 ones;
#pragma unroll
        for (int e = 0; e < 8; ++e) ones[e] = (short)0x3f80;
#pragma unroll
        for (int e = 0; e < 16; ++e) { S[0][e] = 0.f; S[1][e] = 0.f; Ol[e] = 0.f; }
        { QK_READ(0)
#pragma unroll
          for (int ks = 0; ks < 6; ++ks) { S[0] = MFMA32(ka0[ks], qf[ks], S[0]); S[1] = MFMA32(ka1[ks], qf[ks], S[1]); } }
        FIXUP(S, true);
        K_STORE(RA, 1);
        __syncthreads();
        for (int kt = 0; kt < nkt; ++kt) {
            { const int kk = kt + 2 < nkt ? kt + 2 : nkt - 1, kv = kt + 1 < nkt ? kt + 1 : nkt - 1; K_LOAD(RA, kk); V_LOAD(RA, kv); }
            f32x16 Sn[2];
#pragma unroll
            for (int e = 0; e < 16; ++e) { Sn[0][e] = -mbase; Sn[1][e] = -mbase; }
            QK_READ((kt + 1) & 1)
            __builtin_amdgcn_sched_barrier(0);
#pragma unroll
            for (int ks = 0; ks < 6; ++ks) Sn[0] = MFMA32(ka0[ks], qf[ks], Sn[0]);
#pragma unroll
            for (int e = 0; e < 16; ++e) S[0][e] = __builtin_amdgcn_exp2f(S[0][e]);
#pragma unroll
            for (int i2 = 0; i2 < 6; ++i2) { __builtin_amdgcn_sched_group_barrier(0x008, 1, 0); __builtin_amdgcn_sched_group_barrier(0x002, 3, 0); }
            __builtin_amdgcn_sched_barrier(0);
            const LAS char* vb3 = L3 + 2 * A_KB + (kt & 1) * A_VB;
            s16x4 va[2][2][2][2];
#pragma unroll
            for (int dvb = 0; dvb < 2; ++dvb)
#pragma unroll
                for (int kb = 0; kb < 2; ++kb)
#pragma unroll
                    for (int s2 = 0; s2 < 2; ++s2) { const LAS char* vp = vb3 + (dvb * 32 + l31) * AV_STR + (kb * 32 + 16 * s2 + 4 * hh) * 2;
                        va[dvb][kb][s2][0] = *(const LAS s16x4*)vp; va[dvb][kb][s2][1] = *(const LAS s16x4*)(vp + 16); }
            __builtin_amdgcn_sched_barrier(0);
#pragma unroll
            for (int ks = 0; ks < 6; ++ks) Sn[1] = MFMA32(ka1[ks], qf[ks], Sn[1]);
#pragma unroll
            for (int e = 0; e < 16; ++e) S[1][e] = __builtin_amdgcn_exp2f(S[1][e]);
            bf16x8 pb[2][2];
#pragma unroll
            for (int kb = 0; kb < 2; ++kb) { pb[kb][0] = pack8(S[kb], 0); pb[kb][1] = pack8(S[kb], 1); }
#pragma unroll
            for (int i2 = 0; i2 < 6; ++i2) { __builtin_amdgcn_sched_group_barrier(0x008, 1, 0); __builtin_amdgcn_sched_group_barrier(0x002, 6, 0); }
            __builtin_amdgcn_sched_barrier(0);
#pragma unroll
            for (int kb = 0; kb < 2; ++kb)
#pragma unroll
                for (int s2 = 0; s2 < 2; ++s2) {
                    O[0] = MFMA32(cat4(va[0][kb][s2][0], va[0][kb][s2][1]), pb[kb][s2], O[0]);
                    O[1] = MFMA32(cat4(va[1][kb][s2][0], va[1][kb][s2][1]), pb[kb][s2], O[1]);
                    Ol = MFMA32(ones, pb[kb][s2], Ol); }
            K_STORE(RA, kt & 1); V_STORE(RA, (kt + 1) & 1);
            FIXUP(Sn, false);
            __syncthreads();
            S[0] = Sn[0]; S[1] = Sn[1];
        }
#undef QK_READ
#undef FIXUP
#undef K_LOAD
#undef V_LOAD
#undef K_STORE
#undef V_STORE
        const float linv = 1.f / Ol[0];
#pragma unroll
        for (int dvb = 0; dvb < 2; ++dvb)
#pragma unroll
            for (int g = 0; g < 4; ++g) { u32x2 o; o.x = pk2(O[dvb][4 * g] * linv, O[dvb][4 * g + 1] * linv); o.y = pk2(O[dvb][4 * g + 2] * linv, O[dvb][4 * g + 3] * linv);
                *(u32x2*)(AO + (size_t)qrow * 512 + h * 64 + dvb * 32 + 8 * g + 4 * hh) = o; }
    }
}

constexpr size_t WS_BAR = 512 * 1024;
#define XB_TMO      128
#define XB_XCNT(j)  (256  + 64 * (j))
#define XB_XSUB(j)  (1280 + 64 * (j))
#define XB_XGEN(j)  (2304 + 64 * (j))
#define XB_TOP      3328
#define XB_TOPGEN   3392
#define XCD_BAR_WORDS 3456
#define XB_SPIN_CAP (1u << 18)

__device__ __forceinline__ unsigned xb_ld(unsigned* p)              { return __hip_atomic_load(p, __ATOMIC_RELAXED, __HIP_MEMORY_SCOPE_AGENT); }
__device__ __forceinline__ unsigned xb_add(unsigned* p, unsigned v) { return __hip_atomic_fetch_add(p, v, __ATOMIC_RELAXED, __HIP_MEMORY_SCOPE_AGENT); }
__device__ __forceinline__ unsigned xb_xcc_id() { return (unsigned)__builtin_amdgcn_s_getreg((3 << 11) | 20) & 0xFu; }
#define XB_SPIN(cond, bar) do { unsigned _sp = 0; while (cond) { __builtin_amdgcn_s_sleep(1); \
    if ((++_sp & 255u) == 0u) { if (xb_ld(&(bar)[XB_TMO])) break; if (_sp > XB_SPIN_CAP) { atomicAdd(&(bar)[XB_TMO], 1u); break; } } } } while (0)

struct XcdBarrier {
    unsigned* bar; unsigned x;
    volatile LAS unsigned* st;
};

__device__ __forceinline__ XcdBarrier xcd_barrier_post(unsigned* bar, volatile LAS unsigned* st) {
    XcdBarrier b; b.bar = bar; b.x = xb_xcc_id(); b.st = st;
    if (threadIdx.x == 0) (void)xb_add(&bar[XB_XCNT(b.x)], 1u);
    return b;
}
__device__ __forceinline__ void xcd_barrier_complete(unsigned* bar, unsigned x, unsigned& nloc, unsigned& nx) {
    const unsigned G = gridDim.x * gridDim.y * gridDim.z;
    unsigned sum, cnt, mine, sp = 0u;
    for (;;) {
        sum = 0u; cnt = 0u; mine = 0u;
#pragma unroll
        for (unsigned j = 0; j < 16; ++j) { const unsigned c = xb_ld(&bar[XB_XCNT(j)]); sum += c; cnt += (c > 0u) ? 1u : 0u; mine = (j == x) ? c : mine; }
        if (sum == G) break;
        __builtin_amdgcn_s_sleep(1);
        if ((++sp & 255u) == 0u) { if (xb_ld(&bar[XB_TMO])) break; if (sp > XB_SPIN_CAP) { atomicAdd(&bar[XB_TMO], 1u); break; } }
    }
    nloc = mine > 0u ? mine : 1u; nx = cnt > 0u ? cnt : 1u;
}

__device__ __forceinline__ void xcd_barrier(const XcdBarrier& b) {
    asm volatile("s_waitcnt vmcnt(0)" ::: "memory");
    __syncthreads();
    if (threadIdx.x == 0) {
        unsigned* bar = b.bar;
        __builtin_amdgcn_s_waitcnt(0);
        unsigned nloc = b.st[0], nx = b.st[1];
        if (nloc == 0u) { xcd_barrier_complete(bar, b.x, nloc, nx); b.st[0] = nloc; b.st[1] = nx; }
        const unsigned old = xb_add(&bar[XB_XSUB(b.x)], 1u);
        const unsigned gen = old / nloc;
        if (old + 1u == (gen + 1u) * nloc) {
            __builtin_amdgcn_fence(__ATOMIC_RELEASE, "agent");
            asm volatile("s_waitcnt vmcnt(0)" ::: "memory");
            const unsigned og = xb_add(&bar[XB_TOP], 1u);
            const unsigned tg = og / nx;
            if (og + 1u == (tg + 1u) * nx) xb_add(&bar[XB_TOPGEN], 1u);
            else XB_SPIN(xb_ld(&bar[XB_TOPGEN]) == tg, bar);
            __builtin_amdgcn_fence(__ATOMIC_ACQUIRE, "agent");
            xb_add(&bar[XB_XGEN(b.x)], 1u);
            asm volatile("s_waitcnt vmcnt(0)" ::: "memory");
        } else {
            XB_SPIN(xb_ld(&bar[XB_XGEN(b.x)]) == gen, bar);
            __builtin_amdgcn_fence(__ATOMIC_ACQUIRE, "agent");
            asm volatile("s_waitcnt vmcnt(0)" ::: "memory");
        }
    }
    __syncthreads();
}

constexpr int LDS_BYTES = 147456;
constexpr int N_PHASES = 16;
#ifndef PM
#define PM 0x1FFFF
#endif
#define PH(k) ((PM >> (k)) & 1)
#ifndef DUP
#define DUP 0
#endif
#define DP(k) ((DUP >> (k)) & 1)
__global__ void __launch_bounds__(NT, 2) fwd_kernel(Params p_) {
    Params p = p_;
    p.ws = gp_(p_.ws); p.out = gp_(p_.out);
#pragma unroll
    for (int i = 0; i < 27; ++i) p.in[i] = gp_(p_.in[i]);
    extern __shared__ __attribute__((aligned(16))) unsigned char lds[];
    cg::grid_group grid = cg::this_grid();
    unsigned char* ws = lp_(p.ws); unsigned char* dob = (unsigned char*)p.out;
    const int lo = p.ph_lo, hi = p.ph_hi;
    unsigned* barw = (unsigned*)(ws + WS_BAR);
    volatile LAS unsigned* xst = (volatile LAS unsigned*)((LAS unsigned char*)lds + (LDS_BYTES - 64));
    if (tid_() == 0) { xst[0] = 0u; xst[1] = 0u; }
    if (blockIdx.x == 0) { for (int i = tid_(); i < XCD_BAR_WORDS; i += NT) __hip_atomic_store(barw + i, 0u, __ATOMIC_RELAXED, __HIP_MEMORY_SCOPE_AGENT); }
    XcdBarrier xbar; xbar.bar = barw; xbar.x = 0; xbar.st = xst;
#define GSYNC(k) do { if ((k) == lo + 2) { grid.sync(); xbar = xcd_barrier_post(barw, xst); } else xcd_barrier(xbar); } while (0)
#define IN(k) (lo <= (k) && (k) < hi)
#define SEAM(k) do { if (IN(k) && (k) > lo) GSYNC(k); } while (0)
#define RUN_GEMMS(G0, G1) do { if (PH(16)) for (int gi = (G0); gi < (G1); ++gi) { \
            pg8::Gemm g; EpiGen E; E.ws = ws; E.dout = p.out; E.gate_b = p.in[16]; E.ldc = 0; E.hstride = 0; E.out = ws; E.mode = EM_BF16; int boff = 0; \
            const bf16_t* H2 = (const bf16_t*)(ws + WS_H2); \
            switch (gi) { \
            case 0: g = {(const bf16_t*)(dob + DO_H1), (const bf16_t*)(ws + WS_WIN), R, NIN, 1024}; E.mode = EM_IN; break; \
            case 1: g = {(const bf16_t*)(ws + WS_CQ), (const bf16_t*)(ws + WS_WUQ), R, 768, 384}; E.mode = EM_Q; E.out = ws + WS_Q; break; \
            case 2: g = {(const bf16_t*)(dob + DO_KC), (const bf16_t*)(ws + WS_WUK), RK, 512, 256}; E.mode = EM_BF16; E.out = ws + WS_KN; E.ldc = 512; boff = 224; break; \
            case 3: g = {(const bf16_t*)(ws + WS_WV), (const bf16_t*)(dob + DO_KC), 512, RK, 256}; E.mode = EM_BF16; E.out = dob + DO_VT; E.ldc = RK; boff = 208; break; \
            case 4: g = {(const bf16_t*)(ws + WS_MO), (const bf16_t*)(ws + WS_WOM), R, 1024, 512}; E.mode = EM_G1; E.out = ws + WS_Z; break; \
            case 5: g = {(const bf16_t*)(dob + DO_AO), (const bf16_t*)(ws + WS_WOA), R, 1024, 512}; E.mode = EM_G2; E.out = ws + WS_Z; break; \
            case 6: g = {(const bf16_t*)(ws + WS_Z), (const bf16_t*)(ws + WS_WOUT), R, 1024, 1024}; E.mode = EM_BF16; E.out = ws + WS_MG; E.ldc = 1024; break; \
            case 7: g = {H2 + (size_t)RA_ROWS * 1024, (const bf16_t*)(ws + WS_W1), RB_ROWS, 4096, 1024}; E.mode = EM_RELU2; E.out = ws + WS_F1; E.hstride = (size_t)RB_ROWS * 2048; break; \
            case 8: g = {(const bf16_t*)(ws + WS_F1), (const bf16_t*)(ws + WS_W2), RB_ROWS, 1024, 2048}; E.mode = EM_BF16; E.out = ws + WS_P0; E.ldc = 1024; break; \
            case 9: g = {(const bf16_t*)(ws + WS_F1) + (size_t)RB_ROWS * 2048, (const bf16_t*)(ws + WS_W2) + (size_t)1024 * 2048, RB_ROWS, 1024, 2048}; E.mode = EM_BF16; E.out = ws + WS_P1; E.ldc = 1024; boff = 128; break; \
            case 10: g = {H2, (const bf16_t*)(ws + WS_W1), RA_ROWS, 4096, 1024}; E.mode = EM_RELU2; E.out = ws + WS_F1; E.hstride = (size_t)RA_ROWS * 2048; break; \
            case 11: g = {(const bf16_t*)(ws + WS_F1), (const bf16_t*)(ws + WS_W2), RA_ROWS, 1024, 2048}; E.mode = EM_BF16; E.out = ws + WS_P0; E.ldc = 1024; break; \
            default: g = {(const bf16_t*)(ws + WS_F1) + (size_t)RA_ROWS * 2048, (const bf16_t*)(ws + WS_W2) + (size_t)1024 * 2048, RA_ROWS, 1024, 2048}; E.mode = EM_ADD; E.out = ws + WS_P0; E.ldc = 1024; break; \
            } \
            __syncthreads(); \
            pg8::StaticOrder S; S.init(g.M, g.N, (int)gridDim.x, (bid_() + boff) % (int)gridDim.x); \
            pg8::gemm_phase<EpiGen, pg8::StaticOrder, true, true>((PG8_LAS unsigned char*)lds, g, S, E); \
            __syncthreads(); \
        } } while (0)
    if (IN(0)) { if (PH(0)) { phase_A(p, lds, false); __syncthreads(); phase_A(p, lds, true); } if (IN(1) && PH(1)) { __syncthreads(); phase_B(p); } }
    if (IN(1) && !IN(0)) { if (PH(1)) phase_B(p); }
    if (DP(20)) { for (int i = 0; i < 10; ++i) xcd_barrier(xbar); }
    SEAM(2); if (IN(2)) { RUN_GEMMS(0, 1); if (DP(2)) RUN_GEMMS(0, 1); }
    SEAM(3); if (IN(3)) { if (PH(3)) { phase_M1(p, lds); if (DP(3)) phase_M1(p, lds); phase_D(p); } }
    SEAM(4); if (IN(4)) { if (PH(4)) { phase_M2(p, lds); __syncthreads(); phase_M3(p, lds, false, bid_() >= 128 ? bid_() - 128 : -1, 256, 128); } }
    SEAM(5); if (IN(5)) { if (PH(5)) phase_M3(p, lds, false, 256 + bid_(), 768, (int)gridDim.x); }
    SEAM(6); if (IN(6)) { RUN_GEMMS(1, 4); if (DP(6)) RUN_GEMMS(1, 4); }
    SEAM(7); if (IN(7)) { if (PH(7)) phase_attn(p, lds); if (DP(7)) phase_attn(p, lds); }
    for (int ph = (lo > 8 ? lo : 8); ph < hi; ++ph) {
        if (ph > lo) GSYNC(ph);
        int g0 = 0, g1 = 0;
        switch (ph) {
        case 8: g0 = 4; g1 = 6; break;
        case 9: g0 = 6; g1 = 7; break;
        case 10: if (PH(10)) phase_I(p); if (DP(10)) phase_I(p); break;
        case 11: g0 = 7; g1 = 8; break;
        case 12: g0 = 8; g1 = 10; break;
        case 13: if (DP(21)) phase_L(p, RA_ROWS, RB_ROWS, (const bf16_t*)(ws + WS_P0), (const bf16_t*)(ws + WS_P1), true);
                 if (PH(13)) phase_L(p, RA_ROWS, RB_ROWS, (const bf16_t*)(ws + WS_P0), (const bf16_t*)(ws + WS_P1)); g0 = 10; g1 = 11; break;
        case 14: g0 = 11; g1 = 13; break;
        case 15: if (DP(21)) phase_L(p, 0, RA_ROWS, (const bf16_t*)(ws + WS_P0), nullptr, true);
                 if (PH(15)) phase_L(p, 0, RA_ROWS, (const bf16_t*)(ws + WS_P0), nullptr); break;
        }
        RUN_GEMMS(g0, g1);
        if ((DUP >> ph) & 1) RUN_GEMMS(g0, g1);
    }
}

extern "C" void kernel_launch(void* const* d_in, const int* in_sizes, int n_in, void* d_out, int out_size, void* d_ws, size_t ws_size, hipStream_t stream) {
    static int grid = 0;
    if (grid == 0) {
        int dev = 0, cus = 0, per_cu = 0;
        hipGetDevice(&dev); hipDeviceGetAttribute(&cus, hipDeviceAttributeMultiprocessorCount, dev);
        if (hipFuncSetAttribute((const void*)fwd_kernel, hipFuncAttributeMaxDynamicSharedMemorySize, LDS_BYTES) != hipSuccess) fprintf(stderr, "kernel_launch: hipFuncSetAttribute failed\n");
        if (hipOccupancyMaxActiveBlocksPerMultiprocessor(&per_cu, (const void*)fwd_kernel, NT, LDS_BYTES) != hipSuccess || per_cu < 1) { fprintf(stderr, "kernel_launch: occupancy query says %d\n", per_cu); per_cu = 1; }
        (void)hipGetLastError();
        grid = cus * 1;
        if (n_in != 27 || ws_size < WS_END) fprintf(stderr, "kernel_launch: unexpected n_in %d / ws_size %zu\n", n_in, ws_size);
    }
    (void)hipMemsetAsync((unsigned char*)d_ws + WS_ADACNT, 0, 256, stream);
    Params p{};
    for (int i = 0; i < 27; ++i) p.in[i] = (const float*)d_in[i];
    p.out = (float*)d_out; p.ws = (unsigned char*)d_ws;
#ifndef MK_SPLIT
    p.ph_lo = 0; p.ph_hi = N_PHASES;
    void* args[] = {&p};
    hipError_t e = hipLaunchCooperativeKernel((const void*)fwd_kernel, dim3(grid), dim3(NT), args, LDS_BYTES, stream);
    if (e != hipSuccess) fprintf(stderr, "cooperative launch failed: %s (grid %d)\n", hipGetErrorString(e), grid);
#else
    for (int ph = 0; ph < N_PHASES; ++ph) { p.ph_lo = ph; p.ph_hi = ph + 1; hipLaunchKernelGGL(fwd_kernel, dim3(grid), dim3(NT), LDS_BYTES, stream, p); }
#endif
}
```

```cpp
#include <hip/hip_runtime.h>
#include <hip/hip_cooperative_groups.h>
#include <cstdio>
#include <cstdint>
#include <utility>
namespace cg = cooperative_groups;
__device__ __forceinline__ int tid_() { int t = threadIdx.x; asm volatile("" : "+v"(t)); return t; }
__device__ __forceinline__ int bid_() { int b = blockIdx.x; asm volatile("" : "+s"(b)); return b; }
template <class T> __device__ __forceinline__ T* gp_(T* q) { return (T*)(__attribute__((address_space(1))) T*)q; }
template <class T> __device__ __forceinline__ T* lp_(T* q) { return q; }
namespace pg8 {
#define PG8_LAS __attribute__((address_space(3)))
typedef unsigned short bf16_t;
typedef short bf16x8 __attribute__((ext_vector_type(8)));
typedef float f32x4 __attribute__((ext_vector_type(4)));
typedef unsigned u32x4 __attribute__((ext_vector_type(4)));
constexpr int BM = 256, BK = 64, HALF = 128, HTB = HALF * BK * 2  , STAGE_BYTES = 8 * HTB, NXCD = 8, WGM = 8;

__host__ __device__ __forceinline__ int lds_byte(int r, int c) { const int st = (r >> 4) * 2 + (c >> 5), rr = r & 15, cc = c & 31, ob = rr * 64 + cc * 2; return st * 1024 + (ob ^ (((ob >> 9) & 1) << 5)); }
__host__ __device__ __forceinline__ void stage_rc(int b, int& R, int& C) { const int st = b / 1024, sb = b % 1024, swz = sb ^ (((sb >> 9) & 1) << 5); R = (st >> 1) * 16 + swz / 64; C = (st & 1) * 32 + (swz % 64) / 2; }
__host__ __device__ __forceinline__ int perm32(int rho) { const int n = rho >> 4, i = rho & 15; return 8 * (i >> 2) + 4 * n + (i & 3); }

struct Unit { int pm, pn; };
struct Gemm { const bf16_t* A; const bf16_t* Bt; int M, N, K; };

struct StaticOrder {
    int nM, nN, nwg, G, c;
    __host__ __device__ void init(int M, int N, int G_, int c_) { nM = M / BM; nN = N / BM; nwg = nM * nN; G = G_; c = c_; }
    __host__ __device__ bool next(int i, Unit& u) const {
        const long L = (long)i * G + c; if (L >= nwg) return false;
        int wgid = (int)L; { const int q = nwg / NXCD, r = nwg % NXCD, xcd = wgid % NXCD, off = wgid / NXCD; wgid = (xcd < r ? xcd * (q + 1) : r * (q + 1) + (xcd - r) * q) + off; }
        const int nig = WGM * nN, gid = wgid / nig, fm = gid * WGM, gsz = (nM - fm) < WGM ? (nM - fm) : WGM;
        u.pm = fm + ((wgid % nig) % gsz); u.pn = (wgid % nig) / gsz; return true;
    }
    __device__ __forceinline__ void a_ready(const Unit&) const {}
    __device__ __forceinline__ void done(const Unit&) const {}
};
__device__ __forceinline__ unsigned cvt_pk_bf16(float lo, float hi) { unsigned r; asm volatile("v_cvt_pk_bf16_f32 %0, %1, %2" : "=v"(r) : "v"(lo), "v"(hi)); return r; }
template <class Epi, class Sched, bool ALIGN_EPI = false, bool SP2 = false>
__device__ __forceinline__ void gemm_phase(PG8_LAS unsigned char* lds, const Gemm g, const Sched& S, const Epi& E) {
    const int tid = tid_(), wid = __builtin_amdgcn_readfirstlane(tid >> 6), lane = tid & 63, wr = wid >> 2, wc = wid & 3, fr = lane & 15, fq = lane >> 4;
    const int K = g.K, nt = K / BK;
    unsigned voffA[2], voffB[2];
#pragma unroll
    for (int i = 0; i < 2; ++i) { int R, C; stage_rc(tid * 16 + i * 8192, R, C); const int Rb = Epi::PERM ? ((R & ~31) + perm32(R & 31)) : R;
        voffA[i] = (unsigned)(R * K + C) * 2u; voffB[i] = (unsigned)(Rb * K + C) * 2u; }
    const size_t kstep = (size_t)(BK * 2);
    const size_t hstep = (size_t)HALF * K * 2;
    const size_t tstep = 2 * hstep;
    const unsigned ldsw = (unsigned)wid * 1024u;
    const int aoff = lds_byte(wr * 64 + fr, fq * 8), boff = lds_byte(wc * 32 + fr, fq * 8);
#define PG8_SA(b, h) (((b) * 2 + (h)) * HTB)
#define PG8_SB(b, h) ((4 + (b) * 2 + (h)) * HTB)
#define PG8_STAGE(bufoff, gbase, voff) do { _Pragma("unroll") for (int _i = 0; _i < 2; ++_i) \
        __builtin_amdgcn_global_load_lds((const unsigned*)((const char*)(gbase) + (voff)[_i]), (PG8_LAS unsigned*)(lds + (bufoff) + ldsw + _i * 8192), 16, 0, 0); } while (0)
#define PG8_LDA(dst, b, h) do { _Pragma("unroll") for (int m = 0; m < 4; ++m) _Pragma("unroll") for (int k = 0; k < 2; ++k) dst[m][k] = *(const PG8_LAS bf16x8*)(lds + PG8_SA(b, h) + aoff + m * 2048 + k * 1024); } while (0)
#define PG8_LDB(dst, b, h) do { _Pragma("unroll") for (int n = 0; n < 2; ++n) _Pragma("unroll") for (int k = 0; k < 2; ++k) dst[n][k] = *(const PG8_LAS bf16x8*)(lds + PG8_SB(b, h) + boff + n * 2048 + k * 1024); } while (0)
#define PG8_MMA(ai, bj, At, Bt) do { __builtin_amdgcn_s_setprio(1); _Pragma("unroll") for (int m = 0; m < 4; ++m) _Pragma("unroll") for (int n = 0; n < 2; ++n) _Pragma("unroll") for (int k = 0; k < 2; ++k) \
        acc[ai][bj][m][n] = __builtin_amdgcn_mfma_f32_16x16x32_bf16(Bt[n][k], At[m][k], acc[ai][bj][m][n], 0, 0, 0); __builtin_amdgcn_s_setprio(0); } while (0)
#define PG8_WAIT_V(n) asm volatile("s_waitcnt vmcnt(" #n ")" ::: "memory")
#define PG8_WAIT_L(n) asm volatile("s_waitcnt lgkmcnt(" #n ")" ::: "memory")
#define PG8_BAR __builtin_amdgcn_s_barrier()
#define PG8_SCHED __builtin_amdgcn_sched_barrier(0)
    Unit cur, nxt; int ui = 0;
    if (!S.next(0, cur)) return;
    f32x4 acc[2][2][4][2];
#pragma unroll
    for (int a = 0; a < 2; ++a)
#pragma unroll
        for (int b = 0; b < 2; ++b)
#pragma unroll
            for (int m = 0; m < 4; ++m)
#pragma unroll
                for (int n = 0; n < 2; ++n) acc[a][b][m][n] = (f32x4){0.f, 0.f, 0.f, 0.f};
    bf16x8 At[4][2], B0[2][2], B1[2][2];
    const char* cA = (const char*)g.A + (size_t)cur.pm * tstep; const char* cB = (const char*)g.Bt + (size_t)cur.pn * tstep;
    S.a_ready(cur);
    if constexpr (SP2) {
        PG8_STAGE(PG8_SB(0, 0), cB, voffB); PG8_STAGE(PG8_SB(0, 1), cB + hstep, voffB); PG8_STAGE(PG8_SA(0, 0), cA, voffA); PG8_STAGE(PG8_SA(0, 1), cA + hstep, voffA);
        if (wr == 1) PG8_BAR;
        PG8_WAIT_V(2); PG8_BAR;
        PG8_STAGE(PG8_SB(1, 0), cB + kstep, voffB); PG8_STAGE(PG8_SA(1, 0), cA + kstep, voffA); PG8_STAGE(PG8_SB(1, 1), cB + hstep + kstep, voffB);
        PG8_WAIT_V(6); PG8_BAR;
    } else {
        PG8_STAGE(PG8_SB(0, 0), cB, voffB); PG8_STAGE(PG8_SA(0, 0), cA, voffA); PG8_STAGE(PG8_SB(0, 1), cB + hstep, voffB); PG8_STAGE(PG8_SA(0, 1), cA + hstep, voffA);
        if (wr == 1) PG8_BAR;
        PG8_WAIT_V(4); PG8_BAR;
        PG8_STAGE(PG8_SB(1, 0), cB + kstep, voffB); PG8_STAGE(PG8_SA(1, 0), cA + kstep, voffA); PG8_STAGE(PG8_SB(1, 1), cB + hstep + kstep, voffB);
        PG8_WAIT_V(6); PG8_BAR;
    }
    for (;;) {
        const bool has_next = S.next(ui + 1, nxt);
        const char* nA = has_next ? (const char*)g.A + (size_t)nxt.pm * tstep : cA; const char* nB = has_next ? (const char*)g.Bt + (size_t)nxt.pn * tstep : cB;
        for (int t = 0; t < nt; t += 2) {
            const bool last = (t == nt - 2);
            const char* a1 = cA + (size_t)(t + 1) * kstep;
            const char* a2 = last ? nA : cA + (size_t)(t + 2) * kstep; const char* b2 = last ? nB : cB + (size_t)(t + 2) * kstep;
            const char* a3 = a2 + kstep; const char* b3 = b2 + kstep;
            if (last && has_next) S.a_ready(nxt);
            if constexpr (SP2) {
            PG8_LDB(B0, 0, 0); PG8_LDB(B1, 0, 1); PG8_SCHED; PG8_LDA(At, 0, 0); PG8_STAGE(PG8_SA(1, 1), a1 + hstep, voffA);
            PG8_WAIT_V(8); PG8_WAIT_L(0); PG8_BAR; PG8_MMA(0, 0, At, B0); PG8_MMA(0, 1, At, B1); PG8_BAR; PG8_SCHED;
            PG8_LDA(At, 0, 1); PG8_STAGE(PG8_SB(0, 0), b2, voffB); PG8_STAGE(PG8_SB(0, 1), b2 + hstep, voffB); PG8_STAGE(PG8_SA(0, 0), a2, voffA);
            PG8_WAIT_V(8); PG8_WAIT_L(0); PG8_BAR; PG8_MMA(1, 0, At, B0); PG8_MMA(1, 1, At, B1); PG8_BAR; PG8_SCHED;
            PG8_LDB(B0, 1, 0); PG8_LDB(B1, 1, 1); PG8_SCHED; PG8_LDA(At, 1, 0); PG8_STAGE(PG8_SA(0, 1), a2 + hstep, voffA);
            PG8_WAIT_V(8); PG8_WAIT_L(0); PG8_BAR; PG8_MMA(0, 0, At, B0); PG8_MMA(0, 1, At, B1); PG8_BAR; PG8_SCHED;
            PG8_LDA(At, 1, 1); PG8_STAGE(PG8_SB(1, 0), b3, voffB); PG8_STAGE(PG8_SB(1, 1), b3 + hstep, voffB); PG8_STAGE(PG8_SA(1, 0), a3, voffA);
            PG8_WAIT_V(8); PG8_WAIT_L(0); PG8_BAR; PG8_MMA(1, 0, At, B0); PG8_MMA(1, 1, At, B1); PG8_BAR; PG8_SCHED;
            } else {
            PG8_LDB(B0, 0, 0); PG8_SCHED; PG8_LDA(At, 0, 0); PG8_STAGE(PG8_SA(1, 1), a1 + hstep, voffA);
            PG8_WAIT_L(8); PG8_BAR; PG8_WAIT_L(0); PG8_MMA(0, 0, At, B0); PG8_BAR; PG8_SCHED;
            PG8_LDB(B1, 0, 1); PG8_STAGE(PG8_SB(0, 0), b2, voffB);
            PG8_BAR; PG8_WAIT_L(0); PG8_MMA(0, 1, At, B1); PG8_BAR;
            PG8_LDA(At, 0, 1); PG8_STAGE(PG8_SA(0, 0), a2, voffA);
            PG8_BAR; PG8_WAIT_L(0); PG8_MMA(1, 0, At, B0); PG8_BAR; PG8_SCHED;
            PG8_STAGE(PG8_SB(0, 1), b2 + hstep, voffB);
            PG8_WAIT_V(6); PG8_BAR; PG8_MMA(1, 1, At, B1); PG8_BAR;
            PG8_LDB(B0, 1, 0); PG8_SCHED; PG8_LDA(At, 1, 0); PG8_STAGE(PG8_SA(0, 1), a2 + hstep, voffA);
            PG8_WAIT_L(8); PG8_BAR; PG8_WAIT_L(0); PG8_MMA(0, 0, At, B0); PG8_BAR; PG8_SCHED;
            PG8_LDB(B1, 1, 1); PG8_STAGE(PG8_SB(1, 0), b3, voffB);
            PG8_BAR; PG8_WAIT_L(0); PG8_MMA(0, 1, At, B1); PG8_BAR;
            PG8_LDA(At, 1, 1); PG8_STAGE(PG8_SA(1, 0), a3, voffA);
            PG8_BAR; PG8_WAIT_L(0); PG8_MMA(1, 0, At, B0); PG8_BAR; PG8_SCHED;
            PG8_STAGE(PG8_SB(1, 1), b3 + hstep, voffB);
            PG8_WAIT_V(6); PG8_BAR; PG8_MMA(1, 1, At, B1); PG8_BAR;
            }
        }
        if constexpr (ALIGN_EPI) { if (wr == 0) PG8_BAR; }
        if constexpr (!Epi::AFTER_DRAIN) { E(acc, cur, wr, wc, fr, fq); S.done(cur); }
        if (!has_next) break;
#pragma unroll
        for (int a = 0; a < 2; ++a)
#pragma unroll
            for (int b = 0; b < 2; ++b)
#pragma unroll
                for (int m = 0; m < 4; ++m)
#pragma unroll
                    for (int n = 0; n < 2; ++n) acc[a][b][m][n] = (f32x4){0.f, 0.f, 0.f, 0.f};
        cur = nxt; cA = nA; cB = nB; ++ui;
        if constexpr (ALIGN_EPI) { if (wr == 1) PG8_BAR; }
    }
    PG8_WAIT_V(0);
    if constexpr (!ALIGN_EPI) { if (wr == 0) PG8_BAR; }
    PG8_BAR;
    if constexpr (Epi::AFTER_DRAIN) { E.fused(acc, cur, wr, wc, fr, fq, lds, wid, lane); S.done(cur); }
#undef PG8_SA
#undef PG8_SB
#undef PG8_STAGE
#undef PG8_LDA
#undef PG8_LDB
#undef PG8_MMA
#undef PG8_WAIT_V
#undef PG8_WAIT_L
#undef PG8_BAR
#undef PG8_SCHED
}
}

typedef unsigned short bf16_t;
typedef short bf16x8 __attribute__((ext_vector_type(8)));
typedef short s16x4 __attribute__((ext_vector_type(4)));
typedef float f32x4 __attribute__((ext_vector_type(4)));
typedef float f32x16 __attribute__((ext_vector_type(16)));
typedef unsigned u32x4 __attribute__((ext_vector_type(4)));
typedef unsigned u32x2 __attribute__((ext_vector_type(2)));
#define LAS __attribute__((address_space(3)))
#define DI __device__ __forceinline__

constexpr int NT = 512;
constexpr int R = 24576, RC = 8192, RK = 26624;
constexpr int DM = 1024, NIN = 4864;
constexpr size_t MiB = 1u << 20;
constexpr size_t WS_MOD = 0;
constexpr size_t WS_ROPE = 128 * 1024;
constexpr size_t WS_SC = 256 * 1024;
constexpr size_t WS_MP = 384 * 1024;
constexpr size_t WS_ADACNT = 768 * 1024;
constexpr size_t WS_NST = 1 * MiB;
constexpr size_t WS_GATES = 6 * MiB;
constexpr size_t WS_KRRAW = 8 * MiB;
constexpr size_t WS_WIN = 11 * MiB;
constexpr size_t WS_W1 = WS_WIN + (size_t)NIN * 1024 * 2;
constexpr size_t WS_W2 = WS_W1 + 8 * MiB;
constexpr size_t WS_WOUT = WS_W2 + 8 * MiB;
constexpr size_t WS_WOA = WS_WOUT + 2 * MiB;
constexpr size_t WS_WOM = WS_WOA + 1 * MiB;
constexpr size_t WS_WUQ = WS_WOM + 1 * MiB;
constexpr size_t WS_WUK = WS_WUQ + 768 * 384 * 2;
constexpr size_t WS_WV = WS_WUK + 512 * 256 * 2;
static_assert(WS_WV + 512 * 256 * 2 <= 42 * MiB, "weights");
constexpr size_t WS_MQKV = 42 * MiB;
constexpr size_t WS_Q = 42 * MiB;
constexpr size_t WS_KN = 78 * MiB;
constexpr size_t WS_Z = 42 * MiB;
constexpr size_t WS_H2 = 208 * MiB;
constexpr size_t WS_P0 = 42 * MiB, WS_P1 = 58 * MiB;
constexpr size_t WS_F1 = 74 * MiB;
constexpr int RA_ROWS = 16384, RB_ROWS = 8192;
constexpr size_t WS_MO = 114 * MiB;
constexpr size_t WS_MG = 138 * MiB;
constexpr size_t WS_CQ = 234 * MiB;
constexpr size_t WS_KR = 252 * MiB;
constexpr size_t WS_END = 256 * MiB;
constexpr size_t DO_H1 = 0;
constexpr size_t DO_SLOT = 0;
constexpr size_t DO_VT = 0;
constexpr size_t DO_AO = 26 * MiB;
constexpr size_t DO_CKV = 48 * MiB;
constexpr size_t DO_KC = 60 * MiB;
constexpr size_t OUT_CKV = 25165824, OUT_KROPE = 27262976, OUT_C = 27525120, OUT_N = 31719424, OUT_M = 31752192;

struct Params {
    const float* in[27];
    float* out; unsigned char* ws;
    int ph_lo, ph_hi;
};

DI unsigned pk2(float lo, float hi) { unsigned r; asm volatile("v_cvt_pk_bf16_f32 %0, %1, %2" : "=v"(r) : "v"(lo), "v"(hi)); return r; }
DI float bflo(unsigned u) { return __uint_as_float(u << 16); }
DI float bfhi(unsigned u) { return __uint_as_float(u & 0xffff0000u); }
DI float bf1(bf16_t u) { return __uint_as_float(((unsigned)u) << 16); }
DI float sigmoidf_(float x) { return __builtin_amdgcn_rcpf(1.f + __expf(-x)); }
DI float wave_sum(float v) {
#pragma unroll
    for (int o = 1; o < 64; o <<= 1) v += __shfl_xor(v, o);
    return v;
}
DI float wave_max(float v) {
#pragma unroll
    for (int o = 1; o < 64; o <<= 1) v = fmaxf(v, __shfl_xor(v, o));
    return v;
}
DI int crow(int reg, int h) { return (reg & 3) + 8 * (reg >> 2) + 4 * h; }
DI s16x4 tr_read(const LAS char* p) { return __builtin_bit_cast(s16x4, __builtin_amdgcn_ds_read_tr16_b64_v4i16((LAS s16x4*)p)); }
DI bf16x8 cat4(s16x4 a, s16x4 b) { bf16x8 r; r[0] = a[0]; r[1] = a[1]; r[2] = a[2]; r[3] = a[3]; r[4] = b[0]; r[5] = b[1]; r[6] = b[2]; r[7] = b[3]; return r; }
#define MFMA32(a, b, c) __builtin_amdgcn_mfma_f32_32x32x16_bf16((a), (b), (c), 0, 0, 0)
DI bf16x8 pack8(const f32x16& x, int s) {
    u32x4 p; p[0] = pk2(x[8 * s], x[8 * s + 1]); p[1] = pk2(x[8 * s + 2], x[8 * s + 3]); p[2] = pk2(x[8 * s + 4], x[8 * s + 5]); p[3] = pk2(x[8 * s + 6], x[8 * s + 7]);
    return __builtin_bit_cast(bf16x8, p);
}

enum { EM_IN = 0, EM_Q, EM_BF16, EM_G1, EM_G2, EM_F32, EM_RELU2, EM_ADD };
struct EpiGen {
    static constexpr bool PERM = true, AFTER_DRAIN = false;
    int mode; int ldc; size_t hstride;
    void* out;
    unsigned char* ws; float* dout; const float* gate_b;
    DI void st8bf(bf16_t* p, f32x4 a, f32x4 b) const { u32x4 w; w.x = pk2(a[0], a[1]); w.y = pk2(a[2], a[3]); w.z = pk2(b[0], b[1]); w.w = pk2(b[2], b[3]); *(u32x4*)p = w; }
    template <int MODE> DI void one(int row, int col, int pn, f32x4 v0, f32x4 v1) const {
        switch (MODE) {
        case EM_IN: {
            if (pn < 6) {
                const float sc = pn < 2 ? 0.08838834764831845f : 1.f;
                st8bf((bf16_t*)(ws + WS_MQKV) + (size_t)row * 1536 + col, v0 * sc, v1 * sc);
            } else if (pn < 8) {
#pragma unroll
                for (int e = 0; e < 4; ++e) { v0[e] = sigmoidf_(v0[e]); v1[e] = sigmoidf_(v1[e]); }
                st8bf((bf16_t*)(ws + WS_MO) + (size_t)row * 512 + (col - 1536), v0, v1);
            } else if (pn < 11) {
                const int cl = col - 2048;
                if (cl < 384) st8bf((bf16_t*)(ws + WS_CQ) + (size_t)row * 384 + cl, v0, v1);
                else if (cl < 416) { float* d = (float*)(ws + WS_KRRAW) + (size_t)row * 32 + (cl - 384); *(f32x4*)d = v0; *(f32x4*)(d + 4) = v1; }
                else if (cl < 432) {
                    const int gi = cl - 416; f32x4 bi = *(const f32x4*)(gate_b + gi), bfv = *(const f32x4*)(gate_b + gi + 4);
                    f32x4 li = v0 + bi, x = v1 + bfv, lf;
#pragma unroll
                    for (int e = 0; e < 4; ++e) lf[e] = x[e] < -20.f ? x[e] : -__logf(1.f + __expf(-x[e]));
                    float* d = (float*)(ws + WS_GATES) + (size_t)row * 16 + gi; *(f32x4*)d = li; *(f32x4*)(d + 4) = lf;
                } else if (cl < 512) { }
                else st8bf((bf16_t*)((unsigned char*)dout + DO_CKV) + (size_t)row * 256 + (cl - 512), v0, v1);
            } else {
#pragma unroll
                for (int e = 0; e < 4; ++e) { v0[e] = sigmoidf_(v0[e]); v1[e] = sigmoidf_(v1[e]); }
                st8bf((bf16_t*)(ws + WS_MG) + (size_t)row * 2048 + (col - 2816), v0, v1);
            }
        } break;
        case EM_Q: {
            const float sc = 0.10206207261596577f * 1.4426950408889634f;
            const int d = col % 96;
            if (row >= RC && d >= 64) {
                const int t = (row - RC) & 4095, pi0 = (d - 64) >> 1;
                const int pos = pi0 < 8 ? (t >> 6) : (t & 63);
                const float* ct = (const float*)(ws + WS_ROPE) + pos * 8 + (pi0 & 7); const float* stb = ct + 512;
                const f32x4 c = *(const f32x4*)ct, s = *(const f32x4*)stb;
                f32x4 a, b;
                a[0] = v0[0] * c[0] - v0[1] * s[0]; a[1] = v0[0] * s[0] + v0[1] * c[0];
                a[2] = v0[2] * c[1] - v0[3] * s[1]; a[3] = v0[2] * s[1] + v0[3] * c[1];
                b[0] = v1[0] * c[2] - v1[1] * s[2]; b[1] = v1[0] * s[2] + v1[1] * c[2];
                b[2] = v1[2] * c[3] - v1[3] * s[3]; b[3] = v1[2] * s[3] + v1[3] * c[3];
                v0 = a; v1 = b;
            }
            st8bf((bf16_t*)out + (size_t)row * 768 + col, v0 * sc, v1 * sc);
        } break;
        case EM_BF16: st8bf((bf16_t*)out + (size_t)row * ldc + col, v0, v1); break;
        case EM_G1: {
            const u32x4 g = *(const u32x4*)((const bf16_t*)(ws + WS_MG) + (size_t)row * 2048 + col);
            f32x4 a, b; a[0] = v0[0] * bflo(g.x); a[1] = v0[1] * bfhi(g.x); a[2] = v0[2] * bflo(g.y); a[3] = v0[3] * bfhi(g.y);
            b[0] = v1[0] * bflo(g.z); b[1] = v1[1] * bfhi(g.z); b[2] = v1[2] * bflo(g.w); b[3] = v1[3] * bfhi(g.w);
            st8bf((bf16_t*)out + (size_t)row * 1024 + col, a, b);
        } break;
        case EM_G2: {
            const u32x4 g = *(const u32x4*)((const bf16_t*)(ws + WS_MG) + (size_t)row * 2048 + 1024 + col);
            const u32x4 z = *(const u32x4*)((const bf16_t*)out + (size_t)row * 1024 + col);
            f32x4 a, b; a[0] = bflo(z.x) + v0[0] * bflo(g.x); a[1] = bfhi(z.x) + v0[1] * bfhi(g.x); a[2] = bflo(z.y) + v0[2] * bflo(g.y); a[3] = bfhi(z.y) + v0[3] * bfhi(g.y);
            b[0] = bflo(z.z) + v1[0] * bflo(g.z); b[1] = bfhi(z.z) + v1[1] * bfhi(g.z); b[2] = bflo(z.w) + v1[2] * bflo(g.w); b[3] = bfhi(z.w) + v1[3] * bfhi(g.w);
            st8bf((bf16_t*)out + (size_t)row * 1024 + col, a, b);
        } break;
        case EM_F32: { float* d = (float*)out + (size_t)row * ldc + col; *(f32x4*)d = v0; *(f32x4*)(d + 4) = v1; } break;
        case EM_RELU2: {
#pragma unroll
            for (int e = 0; e < 4; ++e) { const float a = v0[e] > 0.f ? v0[e] : 0.f, b = v1[e] > 0.f ? v1[e] : 0.f; v0[e] = a * a; v1[e] = b * b; }
            st8bf((bf16_t*)out + (size_t)(col >> 11) * hstride + (size_t)row * 2048 + (col & 2047), v0, v1);
        } break;
        case EM_ADD: {
            bf16_t* d = (bf16_t*)out + (size_t)row * ldc + col; const u32x4 z = *(const u32x4*)d;
            f32x4 a, b; a[0] = bflo(z.x) + v0[0]; a[1] = bfhi(z.x) + v0[1]; a[2] = bflo(z.y) + v0[2]; a[3] = bfhi(z.y) + v0[3];
            b[0] = bflo(z.z) + v1[0]; b[1] = bfhi(z.z) + v1[1]; b[2] = bflo(z.w) + v1[2]; b[3] = bfhi(z.w) + v1[3];
            st8bf(d, a, b);
        } break;
        }
    }
    template <int MODE, int I> DI void step(const f32x4 (&acc)[2][2][4][2], const pg8::Unit& u, int wr, int wc, int fr, int fq) const {
        constexpr int ai = I >> 3, m = (I >> 1) & 3, bj = I & 1;
        one<MODE>(u.pm * 256 + ai * 128 + wr * 64 + m * 16 + fr, u.pn * 256 + bj * 128 + wc * 32 + 8 * fq, u.pn, acc[ai][bj][m][0], acc[ai][bj][m][1]);
    }
    template <int MODE, int... Is> DI void runseq(std::integer_sequence<int, Is...>, const f32x4 (&acc)[2][2][4][2], const pg8::Unit& u, int wr, int wc, int fr, int fq) const {
        (step<MODE, Is>(acc, u, wr, wc, fr, fq), ...);
    }
    template <int MODE> DI void run(const f32x4 (&acc)[2][2][4][2], const pg8::Unit& u, int wr, int wc, int fr, int fq) const {
        runseq<MODE>(std::make_integer_sequence<int, 16>{}, acc, u, wr, wc, fr, fq);
    }
    DI void operator()(const f32x4 (&acc)[2][2][4][2], const pg8::Unit& u, int wr, int wc, int fr, int fq) const {
        switch (mode) {
        case EM_IN: run<EM_IN>(acc, u, wr, wc, fr, fq); break;
        case EM_Q: run<EM_Q>(acc, u, wr, wc, fr, fq); break;
        case EM_BF16: run<EM_BF16>(acc, u, wr, wc, fr, fq); break;
        case EM_G1: run<EM_G1>(acc, u, wr, wc, fr, fq); break;
        case EM_G2: run<EM_G2>(acc, u, wr, wc, fr, fq); break;
        case EM_F32: run<EM_F32>(acc, u, wr, wc, fr, fq); break;
        case EM_ADD: run<EM_ADD>(acc, u, wr, wc, fr, fq); break;
        default: run<EM_RELU2>(acc, u, wr, wc, fr, fq); break;
        }
    }
};

DI int win_src(int n) {
    if (n < 2048) return n;
    if (n < 2432) return n + 16;
    if (n < 2464) return n - 2432 + 2704;
    if (n < 2480) return n - 2464 + 2048;
    if (n < 2560) return -1;
    if (n < 2816) return n - 2560 + 2448;
    return n - 2816 + 2736;
}
DI void transpose_item(const float* __restrict__ W, int K, int Nsrc, bf16_t* WT, int nblk, int mode, float* scr, int item, int lane) {
    const int kb = item / nblk, nb = item % nblk, k0 = 64 * kb, n0 = 32 * nb;
    const int nd = n0 + (lane & 31);
    int src = nd;
    if (mode == 1) src = win_src(nd); else if (mode == 2) src = (nd >> 6) * 128 + (nd & 63); else if (mode == 3) src = (nd >> 6) * 128 + 64 + (nd & 63);
#pragma unroll 8
    for (int i = 0; i < 32; ++i) { const int kk = 2 * i + (lane >> 5); scr[kk * 33 + (lane & 31)] = src >= 0 ? W[(size_t)(k0 + kk) * Nsrc + src] : 0.f; }
    asm volatile("s_waitcnt lgkmcnt(0)" ::: "memory"); asm volatile("" ::: "memory");
    const int c = lane & 7;
#pragma unroll
    for (int j = 0; j < 4; ++j) { const int n = (lane >> 3) + 8 * j; const float* s = scr + (8 * c) * 33 + n;
        u32x4 o; o.x = pk2(s[0 * 33], s[1 * 33]); o.y = pk2(s[2 * 33], s[3 * 33]); o.z = pk2(s[4 * 33], s[5 * 33]); o.w = pk2(s[6 * 33], s[7 * 33]);
        *(u32x4*)(WT + (size_t)(n0 + n) * K + k0 + 8 * c) = o; }
    asm volatile("s_waitcnt lgkmcnt(0)" ::: "memory"); asm volatile("" ::: "memory");
}
DI void phase_A(const Params& p, unsigned char* lds, const bool late) {
    const int tid = tid_(), lane = tid & 63, wave = tid >> 6;
    unsigned char* ws = lp_(p.ws);
    if (late) { }
    else if (bid_() < 192) {
        float* red = (float*)lds;
        float* sl = (float*)lds + 16 * 5 * 32;
        const float* wa = p.in[9]; const float* cl = p.in[7]; const float* cc = p.in[8];
        for (int e = tid; e < 5 * 1024; e += NT) { const float c = e < 1024 ? cc[e] : cl[e - 1024]; sl[e] = c * sigmoidf_(c); }
        __syncthreads();
        const int col = tid & 31, kg = tid >> 5, n0 = bid_() * 32;
        float acc[5] = {0.f, 0.f, 0.f, 0.f, 0.f};
        for (int k0 = kg; k0 < 1024; k0 += 16 * 8) {
            float w[8];
#pragma unroll
            for (int q = 0; q < 8; ++q) w[q] = wa[(size_t)(k0 + 16 * q) * 6144 + n0 + col];
#pragma unroll
            for (int q = 0; q < 8; ++q)
#pragma unroll
                for (int v = 0; v < 5; ++v) acc[v] += sl[v * 1024 + k0 + 16 * q] * w[q];
        }
#pragma unroll
        for (int v = 0; v < 5; ++v) red[(kg * 5 + v) * 32 + col] = acc[v];
        __syncthreads();
        if (tid < 160) { const int v = tid >> 5, c = tid & 31; float s = 0.f;
            for (int g = 0; g < 16; ++g) s += red[(g * 5 + v) * 32 + c];
            __hip_atomic_store((float*)(ws + WS_MOD) + v * 6144 + n0 + c, s + p.in[10][n0 + c], __ATOMIC_RELAXED, __HIP_MEMORY_SCOPE_AGENT); }
        asm volatile("s_waitcnt vmcnt(0)" ::: "memory");
        __syncthreads();
        if (tid == 0) __hip_atomic_fetch_add((unsigned*)(ws + WS_ADACNT), 1u, __ATOMIC_RELAXED, __HIP_MEMORY_SCOPE_AGENT);
    } else if (bid_() == 255) {
        const int pos = tid >> 3, j = tid & 7;
        double inv = 1.0; for (int i = 0; i < j; ++i) inv *= 0.31622776601683794;
        const double x = (double)pos * inv;
        const double kq = rint(x * 0.6366197723675814); const double r = x - kq * 1.5707963267948966, r2 = r * r;
        const double sn = r * (1.0 + r2 * (-1.0 / 6 + r2 * (1.0 / 120 + r2 * (-1.0 / 5040 + r2 * (1.0 / 362880 + r2 * (-1.0 / 39916800 + r2 * (1.0 / 6227020800.0)))))));
        const double cs = 1.0 + r2 * (-0.5 + r2 * (1.0 / 24 + r2 * (-1.0 / 720 + r2 * (1.0 / 40320 + r2 * (-1.0 / 3628800 + r2 * (1.0 / 479001600.0))))));
        const int q = ((int)kq) & 3;
        const double cv = q == 0 ? cs : (q == 1 ? -sn : (q == 2 ? -cs : sn));
        const double sv = q == 0 ? sn : (q == 1 ? cs : (q == 2 ? -sn : -cs));
        float* T = (float*)(ws + WS_ROPE); T[pos * 8 + j] = (float)cv; T[512 + pos * 8 + j] = (float)sv;
    }
    float* scr = (float*)lds + wave * (64 * 33);
    const int gw = bid_() * 8 + wave, NGW = gridDim.x * 8;
    constexpr int I0 = 16 * 152, I1 = 6 * 24, I2 = 4 * 16, I3 = 4 * 16, I4 = 8 * 32, I5 = 8 * 32, I6 = 16 * 32, I7 = 16 * 128, I8 = 64 * 32;
    constexpr int NITEMS = I0 + I1 + I2 + I3 + I4 + I5 + I6 + I7 + I8;
    for (int it = late ? I0 + gw : gw; it < (late ? NITEMS : I0); it += NGW) {
        int r = it;
        if (r < I0) { transpose_item(p.in[15], 1024, 4784, (bf16_t*)(ws + WS_WIN), 152, 1, scr, r, lane); continue; } r -= I0;
        if (r < I1) { transpose_item(p.in[19], 384, 768, (bf16_t*)(ws + WS_WUQ), 24, 0, scr, r, lane); continue; } r -= I1;
        if (r < I2) { transpose_item(p.in[20], 256, 1024, (bf16_t*)(ws + WS_WUK), 16, 2, scr, r, lane); continue; } r -= I2;
        if (r < I3) { transpose_item(p.in[20], 256, 1024, (bf16_t*)(ws + WS_WV), 16, 3, scr, r, lane); continue; } r -= I3;
        if (r < I4) { transpose_item(p.in[21], 512, 1024, (bf16_t*)(ws + WS_WOA), 32, 0, scr, r, lane); continue; } r -= I4;
        if (r < I5) { transpose_item(p.in[23], 512, 1024, (bf16_t*)(ws + WS_WOM), 32, 0, scr, r, lane); continue; } r -= I5;
        if (r < I6) { transpose_item(p.in[24], 1024, 1024, (bf16_t*)(ws + WS_WOUT), 32, 0, scr, r, lane); continue; } r -= I6;
        if (r < I7) { transpose_item(p.in[25], 1024, 4096, (bf16_t*)(ws + WS_W1), 128, 0, scr, r, lane); continue; } r -= I7;
        if (r < 1024) transpose_item(p.in[26], 2048, 1024, (bf16_t*)(ws + WS_W2), 32, 0, scr, r, lane);
        else transpose_item(p.in[26] + (size_t)2048 * 1024, 2048, 1024, (bf16_t*)(ws + WS_W2) + (size_t)1024 * 2048, 32, 0, scr, r - 1024, lane);
    }
}

DI const float* xrow_ptr(const Params& p, int row) { return row < RC ? p.in[0] + (size_t)row * DM : p.in[1] + (size_t)(row - RC) * DM; }
DI int row_group(int row) { return row < RC ? 0 : 1 + ((row - RC) >> 12); }
DI float ssq4(const f32x4& v) { return (v.x * v.x + v.y * v.y) + (v.z * v.z + v.w * v.w); }
DI void phase_B(const Params& p) {
    constexpr int NR = 4;
    {
        if (tid_() == 0) { unsigned* c = (unsigned*)(lp_(p.ws) + WS_ADACNT); while (__hip_atomic_load(c, __ATOMIC_RELAXED, __HIP_MEMORY_SCOPE_AGENT) < 192u) __builtin_amdgcn_s_sleep(2);
            __builtin_amdgcn_fence(__ATOMIC_ACQUIRE, "agent"); asm volatile("s_waitcnt vmcnt(0)" ::: "memory"); }
        __syncthreads();
    }
    const int lane = tid_() & 63, gw = bid_() * 8 + (tid_() >> 6), NGW = gridDim.x * 8;
    const float* mod = (const float*)(lp_(p.ws) + WS_MOD); const float* nw = p.in[11];
    bf16_t* H1 = (bf16_t*)((unsigned char*)p.out + DO_H1);
    for (int row0 = gw * NR; row0 < R; row0 += NGW * NR) {
        f32x4 v[NR][4]; float s[NR];
#pragma unroll
        for (int r = 0; r < NR; ++r) { const f32x4* xr = (const f32x4*)xrow_ptr(p, row0 + r) + lane;
#pragma unroll
            for (int j = 0; j < 4; ++j) v[r][j] = xr[64 * j]; }
#pragma unroll
        for (int r = 0; r < NR; ++r) { s[r] = 0.f;
#pragma unroll
            for (int j = 0; j < 4; ++j) s[r] += ssq4(v[r][j]);
            s[r] = rsqrtf(wave_sum(s[r]) * (1.f / DM) + 1e-6f); }
        const float* mv = mod + row_group(row0) * 6144;
#pragma unroll
        for (int j = 0; j < 4; ++j) { const int c = 4 * lane + 256 * j;
            const f32x4 w = *(const f32x4*)(nw + c), sh = *(const f32x4*)(mv + c), sc = *(const f32x4*)(mv + 1024 + c);
#pragma unroll
            for (int r = 0; r < NR; ++r) { const f32x4 h = v[r][j] * s[r] * w * (sc + 1.f) + sh;
                u32x2 o; o.x = pk2(h.x, h.y); o.y = pk2(h.z, h.w); *(u32x2*)(H1 + (size_t)(row0 + r) * DM + c) = o; } }
    }
}
DI void phase_I(const Params& p) {
    constexpr int NR = 4;
    const int lane = tid_() & 63, gw = bid_() * 8 + (tid_() >> 6), NGW = gridDim.x * 8;
    const float* mod = (const float*)(lp_(p.ws) + WS_MOD); const float* post1 = p.in[12]; const float* pre2 = p.in[13];
    const bf16_t* MIX = (const bf16_t*)(p.ws + WS_MG); bf16_t* H2 = (bf16_t*)(p.ws + WS_H2);
    for (int row0 = gw * NR; row0 < R; row0 += NGW * NR) {
        f32x4 x[NR][4], m[NR][4]; float rs[NR], rstd[NR];
#pragma unroll
        for (int r = 0; r < NR; ++r) { const f32x4* xr = (const f32x4*)xrow_ptr(p, row0 + r) + lane; const u32x2* mr = (const u32x2*)(MIX + (size_t)(row0 + r) * DM) + lane;
#pragma unroll
            for (int j = 0; j < 4; ++j) { x[r][j] = xr[64 * j]; const u32x2 mm = mr[64 * j]; m[r][j].x = bflo(mm.x); m[r][j].y = bfhi(mm.x); m[r][j].z = bflo(mm.y); m[r][j].w = bfhi(mm.y); } }
#pragma unroll
        for (int r = 0; r < NR; ++r) { float s = 0.f;
#pragma unroll
            for (int j = 0; j < 4; ++j) s += ssq4(m[r][j]);
            rs[r] = rsqrtf(wave_sum(s) * (1.f / DM) + 1e-6f); }
        const float* mv = mod + row_group(row0) * 6144;
#pragma unroll
        for (int r = 0; r < NR; ++r) rstd[r] = 0.f;
#pragma unroll
        for (int j = 0; j < 4; ++j) { const int c = 4 * lane + 256 * j;
            const f32x4 w = *(const f32x4*)(post1 + c), g = *(const f32x4*)(mv + 2048 + c);
#pragma unroll
            for (int r = 0; r < NR; ++r) { x[r][j] = x[r][j] + g * (m[r][j] * rs[r] * w);
                *(f32x4*)(p.out + (size_t)(row0 + r) * DM + c) = x[r][j]; rstd[r] += ssq4(x[r][j]); } }
#pragma unroll
        for (int r = 0; r < NR; ++r) rstd[r] = rsqrtf(wave_sum(rstd[r]) * (1.f / DM) + 1e-6f);
#pragma unroll
        for (int j = 0; j < 4; ++j) { const int c = 4 * lane + 256 * j;
            const f32x4 w = *(const f32x4*)(pre2 + c), sh = *(const f32x4*)(mv + 3072 + c), sc = *(const f32x4*)(mv + 4096 + c);
#pragma unroll
            for (int r = 0; r < NR; ++r) { const f32x4 h = x[r][j] * rstd[r] * w * (sc + 1.f) + sh;
                u32x2 o; o.x = pk2(h.x, h.y); o.y = pk2(h.z, h.w); *(u32x2*)(H2 + (size_t)(row0 + r) * DM + c) = o; } }
    }
}
DI void phase_L(const Params& p, int row_start, int nrows, const bf16_t* F0, const bf16_t* F1, bool dry = false) {
    constexpr int NR = 4;
    const int lane = tid_() & 63, gw = bid_() * 8 + (tid_() >> 6), NGW = gridDim.x * 8;
    const float* mod = (const float*)(lp_(p.ws) + WS_MOD); const float* post2 = p.in[14];
    for (int rl0 = gw * NR; rl0 < nrows; rl0 += NGW * NR) {
        f32x4 f[NR][4], y[NR][4]; float rs[NR];
#pragma unroll
        for (int r = 0; r < NR; ++r) { const u32x2* fr = (const u32x2*)(F0 + (size_t)(rl0 + r) * DM) + lane; const f32x4* yr = (const f32x4*)(p.out + (size_t)(row_start + rl0 + r) * DM) + lane;
#pragma unroll
            for (int j = 0; j < 4; ++j) { const u32x2 ff = fr[64 * j]; f[r][j].x = bflo(ff.x); f[r][j].y = bfhi(ff.x); f[r][j].z = bflo(ff.y); f[r][j].w = bfhi(ff.y); y[r][j] = yr[64 * j]; }
            if (F1) { const u32x2* gr = (const u32x2*)(F1 + (size_t)(rl0 + r) * DM) + lane;
#pragma unroll
                for (int j = 0; j < 4; ++j) { const u32x2 ff = gr[64 * j]; f[r][j].x += bflo(ff.x); f[r][j].y += bfhi(ff.x); f[r][j].z += bflo(ff.y); f[r][j].w += bfhi(ff.y); } } }
#pragma unroll
        for (int r = 0; r < NR; ++r) { float s = 0.f;
#pragma unroll
            for (int j = 0; j < 4; ++j) s += ssq4(f[r][j]);
            rs[r] = rsqrtf(wave_sum(s) * (1.f / DM) + 1e-6f); }
        const float* mv = mod + row_group(row_start + rl0) * 6144;
#pragma unroll
        for (int j = 0; j < 4; ++j) { const int c = 4 * lane + 256 * j;
            const f32x4 w = *(const f32x4*)(post2 + c), g = *(const f32x4*)(mv + 5120 + c);
#pragma unroll
            for (int r = 0; r < NR; ++r) if (!dry || rs[r] == 12345.678f) *(f32x4*)(p.out + (size_t)(row_start + rl0 + r) * DM + c) = y[r][j] + g * (f[r][j] * rs[r] * w); }
    }
}
DI int key_row(int row) { return row < RC ? row : RC + ((row - RC) >> 12) * 4608 + ((row - RC) & 4095); }
DI void phase_D(const Params& p) {
    constexpr int NR = 4;
    const int tid = tid_(), lane = tid & 63, gw = bid_() * 8 + (tid >> 6), NGW = gridDim.x * 8, gt = bid_() * NT + tid, NGT = gridDim.x * NT;
    unsigned char* ws = lp_(p.ws); unsigned char* dob = (unsigned char*)p.out;
    bf16_t* CQ = (bf16_t*)(ws + WS_CQ); const bf16_t* CKV = (const bf16_t*)(dob + DO_CKV); const float* KRR = (const float*)(ws + WS_KRRAW);
    bf16_t* KC = (bf16_t*)(dob + DO_KC); bf16_t* KR = (bf16_t*)(ws + WS_KR); const float* RT = (const float*)(ws + WS_ROPE);
    const float* qn = p.in[17]; const float* kvn = p.in[18];
    for (int row0 = gw * NR; row0 < R; row0 += NGW * NR) {
        unsigned u[NR][3]; u32x2 kv[NR];
#pragma unroll
        for (int r = 0; r < NR; ++r) { const unsigned* cq = (const unsigned*)(CQ + (size_t)(row0 + r) * 384);
#pragma unroll
            for (int j = 0; j < 3; ++j) u[r][j] = cq[lane + 64 * j];
            kv[r] = *(const u32x2*)(CKV + (size_t)(row0 + r) * 256 + 4 * lane); }
#pragma unroll
        for (int r = 0; r < NR; ++r) { const int row = row0 + r; float s = 0.f;
#pragma unroll
            for (int j = 0; j < 3; ++j) { const float a = bflo(u[r][j]), b = bfhi(u[r][j]); s += a * a + b * b; }
            const float rq = rsqrtf(wave_sum(s) * (1.f / 384) + 1e-6f);
            unsigned* cq = (unsigned*)(CQ + (size_t)row * 384);
#pragma unroll
            for (int j = 0; j < 3; ++j) { const int c = 2 * (lane + 64 * j); cq[lane + 64 * j] = pk2(bflo(u[r][j]) * rq * qn[c], bfhi(u[r][j]) * rq * qn[c + 1]); }
            f32x4 v; v.x = bflo(kv[r].x); v.y = bfhi(kv[r].x); v.z = bflo(kv[r].y); v.w = bfhi(kv[r].y);
            const float rk = rsqrtf(wave_sum(ssq4(v)) * (1.f / 256) + 1e-6f);
            v = v * rk * *(const f32x4*)(kvn + 4 * lane);
            u32x2 o; o.x = pk2(v.x, v.y); o.y = pk2(v.z, v.w); *(u32x2*)(KC + (size_t)key_row(row) * 256 + 4 * lane) = o;
            if (row < RC) *(f32x4*)(p.out + OUT_CKV + (size_t)row * 256 + 4 * lane) = v; }
    }
    for (int e = gt; e < R * 16; e += NGT) { const int row = e >> 4, pi = e & 15;
        const float x1 = KRR[(size_t)row * 32 + 2 * pi], x2 = KRR[(size_t)row * 32 + 2 * pi + 1]; float o1 = x1, o2 = x2;
        if (row < RC) { p.out[OUT_KROPE + (size_t)row * 32 + 2 * pi] = x1; p.out[OUT_KROPE + (size_t)row * 32 + 2 * pi + 1] = x2; }
        else { const int t = (row - RC) & 4095, pos = pi < 8 ? (t >> 6) : (t & 63); const float c = RT[pos * 8 + (pi & 7)], sn = RT[512 + pos * 8 + (pi & 7)];
            o1 = x1 * c - x2 * sn; o2 = x1 * sn + x2 * c; }
        *(unsigned*)(KR + (size_t)key_row(row) * 32 + 2 * pi) = pk2(o1, o2); }
    for (int e = gt; e < 2048 * 64; e += NGT) { const int j2 = e >> 6, c4 = e & 63, b = j2 >> 9, j = j2 & 511, kr = RC + b * 4608 + 4096 + j;
        const f32x4 v = *(const f32x4*)(p.in[2] + (size_t)j2 * 256 + 4 * c4);
        u32x2 o; o.x = pk2(v.x, v.y); o.y = pk2(v.z, v.w); *(u32x2*)(KC + (size_t)kr * 256 + 4 * c4) = o; }
    for (int e = gt; e < 2048 * 16; e += NGT) { const int j2 = e >> 4, pi = e & 15, b = j2 >> 9, j = j2 & 511, kr = RC + b * 4608 + 4096 + j;
        *(unsigned*)(KR + (size_t)kr * 32 + 2 * pi) = pk2(p.in[3][(size_t)j2 * 32 + 2 * pi], p.in[3][(size_t)j2 * 32 + 2 * pi + 1]); }
}

constexpr int KT_STR = 320;
constexpr int KR_STR = 272;
DI void scan_add2(float x0, float x1, float& b0, float& b1, int lane) {
    float s = x0 + x1;
#pragma unroll
    for (int o = 1; o < 64; o <<= 1) { const float t = __shfl_up(s, o); if (lane >= o) s += t; }
    b1 = s; b0 = s - x1;
}
DI void scan_max2(float x0, float x1, float& m0, float& m1, int lane) {
    float s = fmaxf(x0, x1);
#pragma unroll
    for (int o = 1; o < 64; o <<= 1) { const float t = __shfl_up(s, o); if (lane >= o) s = fmaxf(s, t); }
    m1 = s; const float prev = __shfl_up(s, 1); m0 = lane > 0 ? fmaxf(prev, x0) : x0;
}
DI int tr_off(int lane, int r0, int c0) { const int i = lane & 15; return (r0 + (i >> 2)) * KT_STR + (c0 + 4 * (i & 3)) * 2; }

DI void phase_M1(const Params& p, unsigned char* lds) {
    const int tid = tid_(), lane = tid & 63, wave = tid >> 6, hh = lane >> 5, g1 = (lane >> 4) & 1;
    unsigned char* ws = lp_(p.ws);
    const bf16_t* MQKV = (const bf16_t*)(ws + WS_MQKV); const float* GATES = (const float*)(ws + WS_GATES);
    bf16_t* SLOT = (bf16_t*)((unsigned char*)p.out + DO_SLOT); float* NST = (float*)(ws + WS_NST); float* SC = (float*)(ws + WS_SC);
    unsigned char* Kt = lds; unsigned char* Vt = lds + 128 * KT_STR; float* wbuf = (float*)(lds + 2 * 128 * KT_STR);
    const LAS char* Kt3 = (const LAS char*)Kt; const LAS char* Vt3 = (const LAS char*)Vt;
#define M1_DECODE(u_, slot_, rowbase_, h_, d_) do { \
        if ((u_) < 512) { const int c = (u_) >> 1, k = (u_) & 1; d_ = c & 1; h_ = (c >> 1) & 3; const int s = c >> 3; rowbase_ = s * 256 + (d_ ? 1 - k : k) * 128; slot_ = 2 * c + k; } \
        else { const int v = (u_) - 512, lc = v / 31, k = v % 31; d_ = lc & 1; h_ = (lc >> 1) & 3; const int b = lc >> 3; rowbase_ = RC + b * 4096 + (d_ ? 31 - k : k) * 128; slot_ = 512 + 32 * lc + k + 1; } } while (0)
#define M1_LOAD(rowbase_, h_, d_) do { \
        _Pragma("unroll") for (int i = 0; i < 4; ++i) { const int id = tid + NT * i, row = id >> 4, ch = id & 15; \
            const bf16_t* src = MQKV + (size_t)((rowbase_) + row) * 1536 + (h_) * 128 + ch * 8; rk[i] = *(const u32x4*)(src + 512); rv[i] = *(const u32x4*)(src + 1024); } \
        if (wave == 0) { const int p0 = 2 * lane, p1 = p0 + 1, t0 = (d_) ? 127 - p0 : p0, t1 = (d_) ? 127 - p1 : p1; \
            gf0 = GATES[(size_t)((rowbase_) + t0) * 16 + (d_) * 8 + 4 + (h_)]; gf1 = GATES[(size_t)((rowbase_) + t1) * 16 + (d_) * 8 + 4 + (h_)]; \
            gi0 = GATES[(size_t)((rowbase_) + t0) * 16 + (d_) * 8 + (h_)]; gi1 = GATES[(size_t)((rowbase_) + t1) * 16 + (d_) * 8 + (h_)]; } } while (0)
    u32x4 rk[4], rv[4]; float gf0 = 0.f, gf1 = 0.f, gi0 = 0.f, gi1 = 0.f;
    int slot = 0, rowbase = 0, h = 0, d = 0;
    if (bid_() < 1504) { M1_DECODE(bid_(), slot, rowbase, h, d); M1_LOAD(rowbase, h, d); }
    for (int u = bid_(); u < 1504; u += gridDim.x) {
        if (wave == 0) {
            const int p0 = 2 * lane, p1 = p0 + 1, t0 = d ? 127 - p0 : p0, t1 = d ? 127 - p1 : p1;
            float b0, b1; scan_add2(gf0, gf1, b0, b1, lane);
            const float bL = __shfl(b1, 63);
            const float ga = bL - b0 + gi0, gb = bL - b1 + gi1, ml = wave_max(fmaxf(ga, gb));
            wbuf[t0] = __expf(ga - ml); wbuf[t1] = __expf(gb - ml);
            if (lane == 0) { SC[slot * 2] = bL; SC[slot * 2 + 1] = ml; }
        }
        __syncthreads();
#pragma unroll
        for (int i = 0; i < 4; ++i) { const int id = tid + NT * i, row = id >> 4, ch = id & 15;
            const u32x4 kv = rk[i]; const float w = wbuf[row];
            u32x4 ko; ko.x = pk2(bflo(kv.x) * w, bfhi(kv.x) * w); ko.y = pk2(bflo(kv.y) * w, bfhi(kv.y) * w); ko.z = pk2(bflo(kv.z) * w, bfhi(kv.z) * w); ko.w = pk2(bflo(kv.w) * w, bfhi(kv.w) * w);
            *(u32x4*)(Kt + row * KT_STR + ch * 16) = ko; *(u32x4*)(Vt + row * KT_STR + ch * 16) = rv[i]; }
        __syncthreads();
        const int cslot = slot;
        { const int un = u + gridDim.x; if (un < 1504) { M1_DECODE(un, slot, rowbase, h, d); M1_LOAD(rowbase, h, d); } }
        const int dvb = wave >> 1, dk0 = 2 * (wave & 1);
        f32x16 acc[2], accn[2];
#pragma unroll
        for (int e = 0; e < 16; ++e) { acc[0][e] = 0.f; acc[1][e] = 0.f; accn[0][e] = 0.f; accn[1][e] = 0.f; }
        bf16x8 ones;
#pragma unroll
        for (int e = 0; e < 8; ++e) ones[e] = (short)0x3f80;
#pragma unroll
        for (int ks = 0; ks < 8; ++ks) {
            const int r0 = 16 * ks + 8 * hh;
            const bf16x8 a = cat4(tr_read(Vt3 + tr_off(lane, r0, dvb * 32 + 16 * g1)), tr_read(Vt3 + tr_off(lane, r0 + 4, dvb * 32 + 16 * g1)));
#pragma unroll
            for (int j = 0; j < 2; ++j) {
                const bf16x8 b = cat4(tr_read(Kt3 + tr_off(lane, r0, (dk0 + j) * 32 + 16 * g1)), tr_read(Kt3 + tr_off(lane, r0 + 4, (dk0 + j) * 32 + 16 * g1)));
                acc[j] = MFMA32(a, b, acc[j]);
                if (dvb == 0) accn[j] = MFMA32(ones, b, accn[j]);
            }
        }
        bf16_t* so = SLOT + (size_t)cslot * 16384;
#pragma unroll
        for (int j = 0; j < 2; ++j)
#pragma unroll
            for (int e = 0; e < 16; ++e) so[(dvb * 32 + crow(e, hh)) * 128 + (dk0 + j) * 32 + (lane & 31)] = (bf16_t)(pk2(acc[j][e], 0.f) & 0xffffu);
        if (dvb == 0 && hh == 0) { NST[(size_t)cslot * 128 + dk0 * 32 + lane] = accn[0][0]; NST[(size_t)cslot * 128 + (dk0 + 1) * 32 + lane] = accn[1][0]; }
        __syncthreads();
    }
}

DI void phase_M2(const Params& p, unsigned char* lds) {
    const int gt = bid_() * NT + tid_();
    unsigned char* ws = lp_(p.ws);
    bf16_t* SLOT = (bf16_t*)((unsigned char*)p.out + DO_SLOT); float* NST = (float*)(ws + WS_NST); const float* SC = (const float*)(ws + WS_SC); float* MP = (float*)(ws + WS_MP);
    if (gt < 65536) {
        const int lc = gt >> 11, v = gt & 2047, dv = v >> 4, dko = v & 15, d = lc & 1, h = (lc >> 1) & 3, b = lc >> 3;
        const float* C0 = p.in[4] + (size_t)((b * 2 + d) * 4 + h) * 16384;
        float C[8];
#pragma unroll
        for (int j = 0; j < 8; ++j) C[j] = C0[(dko * 8 + j) * 128 + dv];
        float m = p.in[6][(b * 2 + d) * 4 + h];
        const int s0 = 512 + 32 * lc;
        { u32x4 o; o.x = pk2(C[0], C[1]); o.y = pk2(C[2], C[3]); o.z = pk2(C[4], C[5]); o.w = pk2(C[6], C[7]); *(u32x4*)(SLOT + (size_t)s0 * 16384 + v * 8) = o; }
        float nv[8];
        const bool isn = v < 16;
        if (isn) {
#pragma unroll
            for (int j = 0; j < 8; ++j) { nv[j] = p.in[5][((b * 2 + d) * 4 + h) * 128 + v * 8 + j]; NST[(size_t)s0 * 128 + v * 8 + j] = nv[j]; }
        }
        if (v == 0) MP[s0] = m;
        for (int k0 = 0; k0 < 31; k0 += 4) {
            u32x4 uu[4]; float bLs[4], mls[4]; float nu[4][8];
#pragma unroll
            for (int q = 0; q < 4; ++q) if (k0 + q < 31) { const int sl = s0 + k0 + q + 1;
                uu[q] = *(const u32x4*)(SLOT + (size_t)sl * 16384 + v * 8); bLs[q] = SC[sl * 2]; mls[q] = SC[sl * 2 + 1];
                if (isn) {
#pragma unroll
                    for (int jj = 0; jj < 8; ++jj) nu[q][jj] = NST[(size_t)sl * 128 + v * 8 + jj]; } }
#pragma unroll
            for (int q = 0; q < 4; ++q) if (k0 + q < 31) { const int sl = s0 + k0 + q + 1;
                const float bL = bLs[q], ml = mls[q];
                const float mn = fmaxf(bL + m, ml), dec = __expf(bL + m - mn), su = __expf(ml - mn);
                C[0] = dec * C[0] + su * bflo(uu[q].x); C[1] = dec * C[1] + su * bfhi(uu[q].x); C[2] = dec * C[2] + su * bflo(uu[q].y); C[3] = dec * C[3] + su * bfhi(uu[q].y);
                C[4] = dec * C[4] + su * bflo(uu[q].z); C[5] = dec * C[5] + su * bfhi(uu[q].z); C[6] = dec * C[6] + su * bflo(uu[q].w); C[7] = dec * C[7] + su * bfhi(uu[q].w);
                u32x4 o; o.x = pk2(C[0], C[1]); o.y = pk2(C[2], C[3]); o.z = pk2(C[4], C[5]); o.w = pk2(C[6], C[7]); *(u32x4*)(SLOT + (size_t)sl * 16384 + v * 8) = o;
                if (isn) {
#pragma unroll
                    for (int jj = 0; jj < 8; ++jj) { nv[jj] = dec * nv[jj] + su * nu[q][jj]; NST[(size_t)sl * 128 + v * 8 + jj] = nv[jj]; } }
                if (v == 0) MP[sl] = mn;
                m = mn; }
        }
    }
    if (bid_() < 128) {
        const int tid = tid_();
        float* T = (float*)lds;
        for (int c = bid_(); c < 256; c += 128) {
            const int d = c & 1, h = (c >> 1) & 3, s = c >> 3;
            const float bL1 = SC[(2 * c + 1) * 2], ml1 = SC[(2 * c + 1) * 2 + 1], ml0 = SC[(2 * c) * 2 + 1];
            const float m1 = ml0;
            const float m2 = fmaxf(bL1 + m1, ml1), dec = __expf(bL1 + m1 - m2), su = __expf(ml1 - m2);
            u32x4 u0[4], u1[4];
#pragma unroll
            for (int q = 0; q < 4; ++q) { const int v = tid + NT * q;
                u0[q] = *(const u32x4*)(SLOT + (size_t)(2 * c) * 16384 + v * 8); u1[q] = *(const u32x4*)(SLOT + (size_t)(2 * c + 1) * 16384 + v * 8); }
#pragma unroll
            for (int q = 0; q < 4; ++q) { const int v = tid + NT * q, dv = v >> 4, dk0 = (v & 15) * 8;
                T[(dk0 + 0) * 129 + dv] = dec * bflo(u0[q].x) + su * bflo(u1[q].x); T[(dk0 + 1) * 129 + dv] = dec * bfhi(u0[q].x) + su * bfhi(u1[q].x);
                T[(dk0 + 2) * 129 + dv] = dec * bflo(u0[q].y) + su * bflo(u1[q].y); T[(dk0 + 3) * 129 + dv] = dec * bfhi(u0[q].y) + su * bfhi(u1[q].y);
                T[(dk0 + 4) * 129 + dv] = dec * bflo(u0[q].z) + su * bflo(u1[q].z); T[(dk0 + 5) * 129 + dv] = dec * bfhi(u0[q].z) + su * bfhi(u1[q].z);
                T[(dk0 + 6) * 129 + dv] = dec * bflo(u0[q].w) + su * bflo(u1[q].w); T[(dk0 + 7) * 129 + dv] = dec * bfhi(u0[q].w) + su * bfhi(u1[q].w); }
            __syncthreads();
            float* oc = p.out + OUT_C + (size_t)((s * 2 + d) * 4 + h) * 16384;
#pragma unroll
            for (int q = 0; q < 8; ++q) { const int e = tid + NT * q, dk = e >> 5, dv4 = (e & 31) * 4;
                f32x4 o; o.x = T[dk * 129 + dv4]; o.y = T[dk * 129 + dv4 + 1]; o.z = T[dk * 129 + dv4 + 2]; o.w = T[dk * 129 + dv4 + 3];
                *(f32x4*)(oc + dk * 128 + dv4) = o; }
            if (tid < 128) {
                p.out[OUT_N + ((s * 2 + d) * 4 + h) * 128 + tid] = dec * NST[(size_t)(2 * c) * 128 + tid] + su * NST[(size_t)(2 * c + 1) * 128 + tid];
                if (tid == 0) { p.out[OUT_M + (s * 2 + d) * 4 + h] = m2; MP[2 * c] = m1; }
            }
            __syncthreads();
        }
    }
}

DI void phase_M3(const Params& p, unsigned char* lds, bool dry, const int u_first, const int u_end, const int u_step) {
    const int tid = tid_(), lane = tid & 63, wave = tid >> 6, hh = lane >> 5, g1 = (lane >> 4) & 1, l31 = lane & 31;
    unsigned char* ws = lp_(p.ws);
    const bf16_t* MQKV = (const bf16_t*)(ws + WS_MQKV); const float* GATES = (const float*)(ws + WS_GATES);
    const bf16_t* SLOT = (const bf16_t*)((unsigned char*)p.out + DO_SLOT); const float* NST = (const float*)(ws + WS_NST); const float* MP = (const float*)(ws + WS_MP);
    bf16_t* MO = (bf16_t*)(ws + WS_MO); const float* hn = p.in[22]; const float* SCm = (const float*)(ws + WS_SC);
    unsigned char* Kt = lds; unsigned char* Vt = lds + 128 * KR_STR;
    float* X = (float*)lds;
    float* ga = (float*)(lds + 128 * KR_STR + 128 * KT_STR);
    float* gc = ga + 256; float* gb = gc + 256; float* gn = gb + 256;
    unsigned char* Qt = lds + 128 * KR_STR + 128 * KT_STR + 4096;
    const LAS char* Kt3 = (const LAS char*)Kt; const LAS char* Vt3 = (const LAS char*)Vt; const LAS char* Qt3 = (const LAS char*)Qt;
#define M3_DECODE(u_) do { \
        if ((u_) < 256) { lat = false; oc = (u_) & 1; h = ((u_) >> 1) & 3; const int s_ = (u_) >> 3; nc = 2; rowbase = s_ * 256 + oc * 128; cbase = (s_ * 4 + h) * 2; } \
        else { lat = true; const int v_ = (u_) - 256; oc = v_ & 31; h = (v_ >> 5) & 3; const int b_ = v_ >> 7; nc = 32; rowbase = RC + b_ * 4096 + oc * 128; cbase = (b_ * 4 + h) * 2; } \
        { const int k0_ = oc, k1_ = nc - 1 - oc; sl0 = lat ? 512 + 32 * cbase + k0_ : (k0_ == 1 ? 2 * cbase : -1); sl1 = lat ? 512 + 32 * (cbase + 1) + k1_ : (k1_ == 1 ? 2 * (cbase + 1) : -1); } } while (0)
#define M3_LOAD() do { \
        _Pragma("unroll") for (int i = 0; i < 4; ++i) { const int id = tid + NT * i, row = id >> 4, ch = id & 15; \
            const bf16_t* src = MQKV + (size_t)(rowbase + row) * 1536 + h * 128 + ch * 8; rq[i] = *(const u32x4*)src; rk[i] = *(const u32x4*)(src + 512); rv[i] = *(const u32x4*)(src + 1024); } \
        if (wave < 2) { const int d_ = wave, sl_ = d_ ? sl1 : sl0; \
            const int p0 = 2 * lane, p1 = p0 + 1, t0 = d_ ? 127 - p0 : p0, t1 = d_ ? 127 - p1 : p1; \
            gf0 = GATES[(size_t)(rowbase + t0) * 16 + d_ * 8 + 4 + h]; gf1 = GATES[(size_t)(rowbase + t1) * 16 + d_ * 8 + 4 + h]; \
            gi0 = GATES[(size_t)(rowbase + t0) * 16 + d_ * 8 + h]; gi1 = GATES[(size_t)(rowbase + t1) * 16 + d_ * 8 + h]; \
            gmp = sl_ >= 0 ? (lat ? MP[sl_] : SCm[sl_ * 2 + 1]) : -1e30f; gn0 = sl_ >= 0 ? NST[(size_t)sl_ * 128 + lane] : 0.f; gn1 = sl_ >= 0 ? NST[(size_t)sl_ * 128 + 64 + lane] : 0.f; } } while (0)
    int rowbase = 0, h = 0, oc = 0, nc = 2, cbase = 0, sl0 = -1, sl1 = -1; bool lat = false;
    u32x4 rq[4], rk[4], rv[4]; float gf0 = 0.f, gf1 = 0.f, gi0 = 0.f, gi1 = 0.f, gmp = 0.f, gn0 = 0.f, gn1 = 0.f;
    if (u_first >= 0 && u_first < u_end) { M3_DECODE(u_first); M3_LOAD(); }
    for (int u = u_first; u >= 0 && u < u_end; u += u_step) {
        if (wave < 2) {
            const int d = wave;
            const int p0 = 2 * lane, p1 = p0 + 1, t0 = d ? 127 - p0 : p0, t1 = d ? 127 - p1 : p1;
            float b0, b1; scan_add2(gf0, gf1, b0, b1, lane);
            const float a0 = gi0 - b0, a1 = gi1 - b1; float m0, m1; scan_max2(a0, a1, m0, m1, lane);
            ga[d * 128 + t0] = a0; ga[d * 128 + t1] = a1; gc[d * 128 + t0] = fmaxf(gmp, m0); gc[d * 128 + t1] = fmaxf(gmp, m1); gb[d * 128 + t0] = b0; gb[d * 128 + t1] = b1;
            gn[d * 128 + lane] = gn0; gn[d * 128 + 64 + lane] = gn1;
        }
#pragma unroll
        for (int i = 0; i < 4; ++i) { const int id = tid + NT * i, row = id >> 4, ch = id & 15;
            *(u32x4*)(Kt + row * KR_STR + ch * 16) = rk[i]; *(u32x4*)(Vt + row * KT_STR + ch * 16) = rv[i]; *(u32x4*)(Qt + row * KR_STR + ch * 16) = rq[i]; }
        __syncthreads();
        const int c_rowbase = rowbase, c_h = h;
        const int d = wave >> 2, tb = wave & 3, t = tb * 32 + l31, sl = d ? sl1 : sl0;
        const float mprev = sl >= 0 ? (u < 256 ? SCm[sl * 2 + 1] : MP[sl]) : -1e30f;
        const LAS char* qrowp = Qt3 + t * KR_STR + 16 * hh;
        const float c_t = gc[d * 128 + t], b_t = gb[d * 128 + t];
        const float si = sl >= 0 ? __expf(mprev - c_t) : 0.f;
        float qn = 0.f;
        if (sl >= 0) {
#pragma unroll
            for (int ks = 0; ks < 8; ++ks) { const bf16x8 q = *(const LAS bf16x8*)(qrowp + 32 * ks);
#pragma unroll
                for (int j = 0; j < 8; ++j) qn += bf1((bf16_t)q[j]) * gn[d * 128 + 16 * ks + 8 * hh + j]; }
        }
        qn += __shfl_xor(qn, 32);
        f32x16 H[4];
#pragma unroll
        for (int i = 0; i < 4; ++i)
#pragma unroll
            for (int e = 0; e < 16; ++e) H[i][e] = 0.f;
        float denp = 0.f;
        const int sb_lo = d ? tb : 0, sb_hi = d ? 3 : tb;
#pragma unroll 1
        for (int sb = sb_lo; sb <= sb_hi; ++sb) {
            f32x16 S;
#pragma unroll
            for (int e = 0; e < 16; ++e) S[e] = 0.f;
#pragma unroll
            for (int ks = 0; ks < 8; ++ks) { const bf16x8 a = *(const LAS bf16x8*)(Kt3 + (sb * 32 + l31) * KR_STR + (16 * ks + 8 * hh) * 2); S = MFMA32(a, *(const LAS bf16x8*)(qrowp + 32 * ks), S); }
#pragma unroll
            for (int e = 0; e < 16; ++e) { const int st = sb * 32 + crow(e, hh); const bool ok = d ? (st >= t) : (st <= t);
                const float w = ok ? __expf(ga[d * 128 + st] - c_t) : 0.f; const float pv = S[e] * w; denp += pv; S[e] = pv; }
            const bf16x8 pb0 = pack8(S, 0), pb1 = pack8(S, 1);
#pragma unroll
            for (int dvb = 0; dvb < 4; ++dvb) {
                const int r0 = sb * 32 + 4 * hh, c0 = dvb * 32 + 16 * g1;
                const bf16x8 a0 = cat4(tr_read(Vt3 + tr_off(lane, r0, c0)), tr_read(Vt3 + tr_off(lane, r0 + 8, c0)));
                const bf16x8 a1 = cat4(tr_read(Vt3 + tr_off(lane, r0 + 16, c0)), tr_read(Vt3 + tr_off(lane, r0 + 24, c0)));
                H[dvb] = MFMA32(a0, pb0, H[dvb]); H[dvb] = MFMA32(a1, pb1, H[dvb]);
            }
        }
        if (sl >= 0) {
            const bf16_t* ct = SLOT + (size_t)sl * 16384;
#pragma unroll
            for (int ks = 0; ks < 8; ++ks) { u32x4 q = *(const LAS u32x4*)(qrowp + 32 * ks);
                q.x = pk2(bflo(q.x) * si, bfhi(q.x) * si); q.y = pk2(bflo(q.y) * si, bfhi(q.y) * si); q.z = pk2(bflo(q.z) * si, bfhi(q.z) * si); q.w = pk2(bflo(q.w) * si, bfhi(q.w) * si);
                const bf16x8 qs = __builtin_bit_cast(bf16x8, q);
#pragma unroll
                for (int dvb = 0; dvb < 4; ++dvb) { const bf16x8 a = *(const bf16x8*)(ct + (dvb * 32 + l31) * 128 + 16 * ks + 8 * hh); H[dvb] = MFMA32(a, qs, H[dvb]); }
            }
        }
        const float den = si * qn + (denp + __shfl_xor(denp, 32));
        const float inv = 1.f / fmaxf(fabsf(den), __expf(-(c_t + b_t)));
#pragma unroll
        for (int i = 0; i < 4; ++i)
#pragma unroll
            for (int e = 0; e < 16; ++e) H[i][e] *= inv;
        __syncthreads();
        { const int un = u + u_step; if (un < u_end) { M3_DECODE(un); M3_LOAD(); } }
        if (d == 1) {
#pragma unroll
            for (int dvb = 0; dvb < 4; ++dvb)
#pragma unroll
                for (int g = 0; g < 4; ++g) { f32x4 v; v.x = H[dvb][4 * g]; v.y = H[dvb][4 * g + 1]; v.z = H[dvb][4 * g + 2]; v.w = H[dvb][4 * g + 3]; *(f32x4*)(X + t * 132 + dvb * 32 + 8 * g + 4 * hh) = v; }
        }
        __syncthreads();
        if (d == 0) {
            float ss = 0.f;
#pragma unroll
            for (int dvb = 0; dvb < 4; ++dvb)
#pragma unroll
                for (int g = 0; g < 4; ++g) { const f32x4 v = *(const f32x4*)(X + t * 132 + dvb * 32 + 8 * g + 4 * hh);
                    H[dvb][4 * g] += v.x; H[dvb][4 * g + 1] += v.y; H[dvb][4 * g + 2] += v.z; H[dvb][4 * g + 3] += v.w;
                    ss += (H[dvb][4 * g] * H[dvb][4 * g] + H[dvb][4 * g + 1] * H[dvb][4 * g + 1]) + (H[dvb][4 * g + 2] * H[dvb][4 * g + 2] + H[dvb][4 * g + 3] * H[dvb][4 * g + 3]); }
            ss += __shfl_xor(ss, 32);
            const float rstd = rsqrtf(ss * (1.f / 128) + 1e-6f);
#pragma unroll
            for (int dvb = 0; dvb < 4; ++dvb)
#pragma unroll
                for (int g = 0; g < 4; ++g) { const int dv = dvb * 32 + 8 * g + 4 * hh; const f32x4 w = *(const f32x4*)(hn + c_h * 128 + dv);
                    u32x2* mp = (u32x2*)(MO + (size_t)(c_rowbase + t) * 512 + c_h * 128 + dv); const u32x2 mo = *mp;
                    u32x2 o; o.x = pk2(H[dvb][4 * g] * rstd * w.x * bflo(mo.x), H[dvb][4 * g + 1] * rstd * w.y * bfhi(mo.x));
                    o.y = pk2(H[dvb][4 * g + 2] * rstd * w.z * bflo(mo.y), H[dvb][4 * g + 3] * rstd * w.w * bfhi(mo.y)); if (!dry || rstd == 12345.678f) *mp = o; }
        }
        __syncthreads();
    }
}

constexpr int AK_STR = 208;
constexpr int AV_STR = 136;
constexpr int A_KB = 64 * AK_STR, A_VB = 64 * AV_STR;
DI float max3f(float a, float b, float c) { float r; asm("v_max3_f32 %0, %1, %2, %3" : "=v"(r) : "v"(a), "v"(b), "v"(c)); return r; }
struct AStage { u32x4 k0, k1, v; };
DI void phase_attn(const Params& p, unsigned char* lds) {
    const int tid = tid_(), lane = tid & 63, wave = tid >> 6, hh = lane >> 5, l31 = lane & 31;
    unsigned char* ws = lp_(p.ws); unsigned char* dob = (unsigned char*)p.out;
    const bf16_t* Q = (const bf16_t*)(ws + WS_Q); const bf16_t* KN = (const bf16_t*)(ws + WS_KN); const bf16_t* KR = (const bf16_t*)(ws + WS_KR);
    const bf16_t* VT = (const bf16_t*)(dob + DO_VT); bf16_t* AO = (bf16_t*)(dob + DO_AO);
    const LAS char* L3 = (const LAS char*)lds;
    const int id1 = (tid + 512) % 768;
    const int kkey0 = tid / 12, kch0 = tid % 12, kkey1 = id1 / 12, kch1 = id1 % 12;
    const int vdv = tid >> 3, vch = tid & 7;
    for (int u = bid_(); u < 768; u += gridDim.x) {
        int qrow0, keybase, nkt, h;
        if (u < 512) {
            const int r = u >> 8, i = u & 255, xcd = i & 7, slot = i >> 3, bh = r * 16 + xcd * 2 + (slot >> 4), qb = slot & 15; h = bh & 7; const int b = bh >> 3;
            qrow0 = RC + b * 4096 + qb * 256; keybase = RC + b * 4608; nkt = 72; }
        else { const int v = u - 512; h = v & 7; const int b = v >> 3; qrow0 = b * 256; keybase = b * 256; nkt = 4; }
        const int qrow = qrow0 + wave * 32 + l31;
        bf16x8 qf[6];
#pragma unroll
        for (int ks = 0; ks < 6; ++ks) qf[ks] = *(const bf16x8*)(Q + (size_t)qrow * 768 + h * 96 + 16 * ks + 8 * hh);
        f32x16 O[2];
#pragma unroll
        for (int e = 0; e < 16; ++e) { O[0][e] = 0.f; O[1][e] = 0.f; }
        const bf16_t* kp0 = kch0 < 8 ? KN + (size_t)(keybase + kkey0) * 512 + h * 64 + kch0 * 8 : KR + (size_t)(keybase + kkey0) * 32 + (kch0 - 8) * 8;
        const bf16_t* kp1 = kch1 < 8 ? KN + (size_t)(keybase + kkey1) * 512 + h * 64 + kch1 * 8 : KR + (size_t)(keybase + kkey1) * 32 + (kch1 - 8) * 8;
        const int ks0 = kch0 < 8 ? 64 * 512 : 64 * 32, ks1 = kch1 < 8 ? 64 * 512 : 64 * 32;
        const bf16_t* vp0 = VT + (size_t)(h * 64 + vdv) * RK + keybase + vch * 8;
#define K_LOAD(st, kt) do { (st).k0 = *(const u32x4*)(kp0 + (size_t)(kt) * ks0); (st).k1 = *(const u32x4*)(kp1 + (size_t)(kt) * ks1); } while (0)
#define V_LOAD(st, kt) do { (st).v = *(const u32x4*)(vp0 + (kt) * 64); } while (0)
#define K_STORE(st, buf) do { unsigned char* b_ = lds + (buf) * A_KB; *(u32x4*)(b_ + kkey0 * AK_STR + kch0 * 16) = (st).k0; *(u32x4*)(b_ + kkey1 * AK_STR + kch1 * 16) = (st).k1; } while (0)
#define V_STORE(st, buf) do { unsigned char* b_ = lds + 2 * A_KB + (buf) * A_VB; u32x2 lo_, hi_; lo_.x = (st).v.x; lo_.y = (st).v.y; hi_.x = (st).v.z; hi_.y = (st).v.w; \
            *(u32x2*)(b_ + vdv * AV_STR + vch * 16) = lo_; *(u32x2*)(b_ + vdv * AV_STR + vch * 16 + 8) = hi_; } while (0)
#define QK_READ(buf) const LAS char* kb3_ = L3 + (buf) * A_KB; bf16x8 ka0[6], ka1[6]; \
            _Pragma("unroll") for (int ks = 0; ks < 6; ++ks) ka0[ks] = *(const LAS bf16x8*)(kb3_ + l31 * AK_STR + (16 * ks + 8 * hh) * 2); \
            _Pragma("unroll") for (int ks = 0; ks < 6; ++ks) ka1[ks] = *(const LAS bf16x8*)(kb3_ + (32 + l31) * AK_STR + (16 * ks + 8 * hh) * 2);
#define FIXUP(Sx, forced) do { \
            float tm = max3f(Sx[0][0], Sx[1][0], Sx[0][1]); \
            _Pragma("unroll") for (int e = 1; e < 15; e += 2) { tm = max3f(tm, Sx[1][e], Sx[0][e + 1]); tm = max3f(tm, Sx[1][e + 1], Sx[0][e + 2]); } \
            tm = fmaxf(tm, Sx[1][15]); tm = fmaxf(tm, __shfl_xor(tm, 32)); \
            if ((forced) || __builtin_amdgcn_ballot_w64(tm > 8.f) != 0ull) { \
                const float delta = (forced) ? tm : fmaxf(tm, 0.f); const float alpha = __builtin_amdgcn_exp2f(-delta); \
                _Pragma("unroll") for (int e = 0; e < 16; ++e) { Sx[0][e] -= delta; Sx[1][e] -= delta; O[0][e] *= alpha; O[1][e] *= alpha; Ol[e] *= alpha; } \
                mbase += delta; } } while (0)
        AStage RA;
        K_LOAD(RA, 0); V_LOAD(RA, 0); K_STORE(RA, 0); V_STORE(RA, 0);
        K_LOAD(RA, 1);
        __syncthreads();
        f32x16 S[2], Ol; float mbase = 0.f;
        bf16x8 ones;
#pragma unroll
        for (int e = 0; e < 8; ++e) ones[e] = (short)0x3f80;
#pragma unroll
        for (int e = 0; e < 16; ++e) { S[0][e] = 0.f; S[1][e] = 0.f; Ol[e] = 0.f; }
        { QK_READ(0)
#pragma unroll
          for (int ks = 0; ks < 6; ++ks) { S[0] = MFMA32(ka0[ks], qf[ks], S[0]); S[1] = MFMA32(ka1[ks], qf[ks], S[1]); } }
        FIXUP(S, true);
        K_STORE(RA, 1);
        __syncthreads();
        for (int kt = 0; kt < nkt; ++kt) {
            { const int kk = kt + 2 < nkt ? kt + 2 : nkt - 1, kv = kt + 1 < nkt ? kt + 1 : nkt - 1; K_LOAD(RA, kk); V_LOAD(RA, kv); }
            f32x16 Sn[2];
#pragma unroll
            for (int e = 0; e < 16; ++e) { Sn[0][e] = -mbase; Sn[1][e] = -mbase; }
            QK_READ((kt + 1) & 1)
            __builtin_amdgcn_sched_barrier(0);
#pragma unroll
            for (int ks = 0; ks < 6; ++ks) Sn[0] = MFMA32(ka0[ks], qf[ks], Sn[0]);
#pragma unroll
            for (int e = 0; e < 16; ++e) S[0][e] = __builtin_amdgcn_exp2f(S[0][e]);
#pragma unroll
            for (int i2 = 0; i2 < 6; ++i2) { __builtin_amdgcn_sched_group_barrier(0x008, 1, 0); __builtin_amdgcn_sched_group_barrier(0x002, 3, 0); }
            __builtin_amdgcn_sched_barrier(0);
            const LAS char* vb3 = L3 + 2 * A_KB + (kt & 1) * A_VB;
            s16x4 va[2][2][2][2];
#pragma unroll
            for (int dvb = 0; dvb < 2; ++dvb)
#pragma unroll
                for (int kb = 0; kb < 2; ++kb)
#pragma unroll
                    for (int s2 = 0; s2 < 2; ++s2) { const LAS char* vp = vb3 + (dvb * 32 + l31) * AV_STR + (kb * 32 + 16 * s2 + 4 * hh) * 2;
                        va[dvb][kb][s2][0] = *(const LAS s16x4*)vp; va[dvb][kb][s2][1] = *(const LAS s16x4*)(vp + 16); }
            __builtin_amdgcn_sched_barrier(0);
#pragma unroll
            for (int ks = 0; ks < 6; ++ks) Sn[1] = MFMA32(ka1[ks], qf[ks], Sn[1]);
#pragma unroll
            for (int e = 0; e < 16; ++e) S[1][e] = __builtin_amdgcn_exp2f(S[1][e]);
            bf16x8 pb[2][2];
#pragma unroll
            for (int kb = 0; kb < 2; ++kb) { pb[kb][0] = pack8(S[kb], 0); pb[kb][1] = pack8(S[kb], 1); }
#pragma unroll
            for (int i2 = 0; i2 < 6; ++i2) { __builtin_amdgcn_sched_group_barrier(0x008, 1, 0); __builtin_amdgcn_sched_group_barrier(0x002, 6, 0); }
            __builtin_amdgcn_sched_barrier(0);
#pragma unroll
            for (int kb = 0; kb < 2; ++kb)
#pragma unroll
                for (int s2 = 0; s2 < 2; ++s2) {
                    O[0] = MFMA32(cat4(va[0][kb][s2][0], va[0][kb][s2][1]), pb[kb][s2], O[0]);
                    O[1] = MFMA32(cat4(va[1][kb][s2][0], va[1][kb][s2][1]), pb[kb][s2], O[1]);
                    Ol = MFMA32(ones, pb[kb][s2], Ol); }
            K_STORE(RA, kt & 1); V_STORE(RA, (kt + 1) & 1);
            FIXUP(Sn, false);
            __syncthreads();
            S[0] = Sn[0]; S[1] = Sn[1];
        }
#undef QK_READ
#undef FIXUP
#undef K_LOAD
#undef V_LOAD
#undef K_STORE
#undef V_STORE
        const float linv = 1.f / Ol[0];
#pragma unroll
        for (int dvb = 0; dvb < 2; ++dvb)
#pragma unroll
            for (int g = 0; g < 4; ++g) { u32x2 o; o.x = pk2(O[dvb][4 * g] * linv, O[dvb][4 * g + 1] * linv); o.y = pk2(O[dvb][4 * g + 2] * linv, O[dvb][4 * g + 3] * linv);
                *(u32x2*)(AO + (size_t)qrow * 512 + h * 64 + dvb * 32 + 8 * g + 4 * hh) = o; }
    }
}

constexpr size_t WS_BAR = 512 * 1024;
#define XB_TMO      128
#define XB_XCNT(j)  (256  + 64 * (j))
#define XB_XSUB(j)  (1280 + 64 * (j))
#define XB_XGEN(j)  (2304 + 64 * (j))
#define XB_TOP      3328
#define XB_TOPGEN   3392
#define XCD_BAR_WORDS 3456
#define XB_SPIN_CAP (1u << 18)

__device__ __forceinline__ unsigned xb_ld(unsigned* p)              { return __hip_atomic_load(p, __ATOMIC_RELAXED, __HIP_MEMORY_SCOPE_AGENT); }
__device__ __forceinline__ unsigned xb_add(unsigned* p, unsigned v) { return __hip_atomic_fetch_add(p, v, __ATOMIC_RELAXED, __HIP_MEMORY_SCOPE_AGENT); }
__device__ __forceinline__ unsigned xb_xcc_id() { return (unsigned)__builtin_amdgcn_s_getreg((3 << 11) | 20) & 0xFu; }
#define XB_SPIN(cond, bar) do { unsigned _sp = 0; while (cond) { __builtin_amdgcn_s_sleep(1); \
    if ((++_sp & 255u) == 0u) { if (xb_ld(&(bar)[XB_TMO])) break; if (_sp > XB_SPIN_CAP) { atomicAdd(&(bar)[XB_TMO], 1u); break; } } } } while (0)

struct XcdBarrier {
    unsigned* bar; unsigned x;
    volatile LAS unsigned* st;
};

__device__ __forceinline__ XcdBarrier xcd_barrier_post(unsigned* bar, volatile LAS unsigned* st) {
    XcdBarrier b; b.bar = bar; b.x = xb_xcc_id(); b.st = st;
    if (threadIdx.x == 0) (void)xb_add(&bar[XB_XCNT(b.x)], 1u);
    return b;
}
__device__ __forceinline__ void xcd_barrier_complete(unsigned* bar, unsigned x, unsigned& nloc, unsigned& nx) {
    const unsigned G = gridDim.x * gridDim.y * gridDim.z;
    unsigned sum, cnt, mine, sp = 0u;
    for (;;) {
        sum = 0u; cnt = 0u; mine = 0u;
#pragma unroll
        for (unsigned j = 0; j < 16; ++j) { const unsigned c = xb_ld(&bar[XB_XCNT(j)]); sum += c; cnt += (c > 0u) ? 1u : 0u; mine = (j == x) ? c : mine; }
        if (sum == G) break;
        __builtin_amdgcn_s_sleep(1);
        if ((++sp & 255u) == 0u) { if (xb_ld(&bar[XB_TMO])) break; if (sp > XB_SPIN_CAP) { atomicAdd(&bar[XB_TMO], 1u); break; } }
    }
    nloc = mine > 0u ? mine : 1u; nx = cnt > 0u ? cnt : 1u;
}

__device__ __forceinline__ void xcd_barrier(const XcdBarrier& b) {
    asm volatile("s_waitcnt vmcnt(0)" ::: "memory");
    __syncthreads();
    if (threadIdx.x == 0) {
        unsigned* bar = b.bar;
        __builtin_amdgcn_s_waitcnt(0);
        unsigned nloc = b.st[0], nx = b.st[1];
        if (nloc == 0u) { xcd_barrier_complete(bar, b.x, nloc, nx); b.st[0] = nloc; b.st[1] = nx; }
        const unsigned old = xb_add(&bar[XB_XSUB(b.x)], 1u);
        const unsigned gen = old / nloc;
        if (old + 1u == (gen + 1u) * nloc) {
            __builtin_amdgcn_fence(__ATOMIC_RELEASE, "agent");
            asm volatile("s_waitcnt vmcnt(0)" ::: "memory");
            const unsigned og = xb_add(&bar[XB_TOP], 1u);
            const unsigned tg = og / nx;
            if (og + 1u == (tg + 1u) * nx) xb_add(&bar[XB_TOPGEN], 1u);
            else XB_SPIN(xb_ld(&bar[XB_TOPGEN]) == tg, bar);
            __builtin_amdgcn_fence(__ATOMIC_ACQUIRE, "agent");
            xb_add(&bar[XB_XGEN(b.x)], 1u);
            asm volatile("s_waitcnt vmcnt(0)" ::: "memory");
        } else {
            XB_SPIN(xb_ld(&bar[XB_XGEN(b.x)]) == gen, bar);
            __builtin_amdgcn_fence(__ATOMIC_ACQUIRE, "agent");
            asm volatile("s_waitcnt vmcnt(0)" ::: "memory");
        }
    }
    __syncthreads();
}

constexpr int LDS_BYTES = 147456;
constexpr int N_PHASES = 16;
#ifndef PM
#define PM 0x1FFFF
#endif
#define PH(k) ((PM >> (k)) & 1)
#ifndef DUP
#define DUP 0
#endif
#define DP(k) ((DUP >> (k)) & 1)
__global__ void __launch_bounds__(NT, 2) fwd_kernel(Params p_) {
    Params p = p_;
    p.ws = gp_(p_.ws); p.out = gp_(p_.out);
#pragma unroll
    for (int i = 0; i < 27; ++i) p.in[i] = gp_(p_.in[i]);
    extern __shared__ __attribute__((aligned(16))) unsigned char lds[];
    cg::grid_group grid = cg::this_grid();
    unsigned char* ws = lp_(p.ws); unsigned char* dob = (unsigned char*)p.out;
    const int lo = p.ph_lo, hi = p.ph_hi;
    unsigned* barw = (unsigned*)(ws + WS_BAR);
    volatile LAS unsigned* xst = (volatile LAS unsigned*)((LAS unsigned char*)lds + (LDS_BYTES - 64));
    if (tid_() == 0) { xst[0] = 0u; xst[1] = 0u; }
    if (blockIdx.x == 0) { for (int i = tid_(); i < XCD_BAR_WORDS; i += NT) __hip_atomic_store(barw + i, 0u, __ATOMIC_RELAXED, __HIP_MEMORY_SCOPE_AGENT); }
    XcdBarrier xbar; xbar.bar = barw; xbar.x = 0; xbar.st = xst;
#define GSYNC(k) do { if ((k) == lo + 2) { grid.sync(); xbar = xcd_barrier_post(barw, xst); } else xcd_barrier(xbar); } while (0)
#define IN(k) (lo <= (k) && (k) < hi)
#define SEAM(k) do { if (IN(k) && (k) > lo) GSYNC(k); } while (0)
#define RUN_GEMMS(G0, G1) do { if (PH(16)) for (int gi = (G0); gi < (G1); ++gi) { \
            pg8::Gemm g; EpiGen E; E.ws = ws; E.dout = p.out; E.gate_b = p.in[16]; E.ldc = 0; E.hstride = 0; E.out = ws; E.mode = EM_BF16; int boff = 0; \
            const bf16_t* H2 = (const bf16_t*)(ws + WS_H2); \
            switch (gi) { \
            case 0: g = {(const bf16_t*)(dob + DO_H1), (const bf16_t*)(ws + WS_WIN), R, NIN, 1024}; E.mode = EM_IN; break; \
            case 1: g = {(const bf16_t*)(ws + WS_CQ), (const bf16_t*)(ws + WS_WUQ), R, 768, 384}; E.mode = EM_Q; E.out = ws + WS_Q; break; \
            case 2: g = {(const bf16_t*)(dob + DO_KC), (const bf16_t*)(ws + WS_WUK), RK, 512, 256}; E.mode = EM_BF16; E.out = ws + WS_KN; E.ldc = 512; boff = 224; break; \
            case 3: g = {(const bf16_t*)(ws + WS_WV), (const bf16_t*)(dob + DO_KC), 512, RK, 256}; E.mode = EM_BF16; E.out = dob + DO_VT; E.ldc = RK; boff = 208; break; \
            case 4: g = {(const bf16_t*)(ws + WS_MO), (const bf16_t*)(ws + WS_WOM), R, 1024, 512}; E.mode = EM_G1; E.out = ws + WS_Z; break; \
            case 5: g = {(const bf16_t*)(dob + DO_AO), (const bf16_t*)(ws + WS_WOA), R, 1024, 512}; E.mode = EM_G2; E.out = ws + WS_Z; break; \
            case 6: g = {(const bf16_t*)(ws + WS_Z), (const bf16_t*)(ws + WS_WOUT), R, 1024, 1024}; E.mode = EM_BF16; E.out = ws + WS_MG; E.ldc = 1024; break; \
            case 7: g = {H2 + (size_t)RA_ROWS * 1024, (const bf16_t*)(ws + WS_W1), RB_ROWS, 4096, 1024}; E.mode = EM_RELU2; E.out = ws + WS_F1; E.hstride = (size_t)RB_ROWS * 2048; break; \
            case 8: g = {(const bf16_t*)(ws + WS_F1), (const bf16_t*)(ws + WS_W2), RB_ROWS, 1024, 2048}; E.mode = EM_BF16; E.out = ws + WS_P0; E.ldc = 1024; break; \
            case 9: g = {(const bf16_t*)(ws + WS_F1) + (size_t)RB_ROWS * 2048, (const bf16_t*)(ws + WS_W2) + (size_t)1024 * 2048, RB_ROWS, 1024, 2048}; E.mode = EM_BF16; E.out = ws + WS_P1; E.ldc = 1024; boff = 128; break; \
            case 10: g = {H2, (const bf16_t*)(ws + WS_W1), RA_ROWS, 4096, 1024}; E.mode = EM_RELU2; E.out = ws + WS_F1; E.hstride = (size_t)RA_ROWS * 2048; break; \
            case 11: g = {(const bf16_t*)(ws + WS_F1), (const bf16_t*)(ws + WS_W2), RA_ROWS, 1024, 2048}; E.mode = EM_BF16; E.out = ws + WS_P0; E.ldc = 1024; break; \
            default: g = {(const bf16_t*)(ws + WS_F1) + (size_t)RA_ROWS * 2048, (const bf16_t*)(ws + WS_W2) + (size_t)1024 * 2048, RA_ROWS, 1024, 2048}; E.mode = EM_ADD; E.out = ws + WS_P0; E.ldc = 1024; break; \
            } \
            __syncthreads(); \
            pg8::StaticOrder S; S.init(g.M, g.N, (int)gridDim.x, (bid_() + boff) % (int)gridDim.x); \
            pg8::gemm_phase<EpiGen, pg8::StaticOrder, true, true>((PG8_LAS unsigned char*)lds, g, S, E); \
            __syncthreads(); \
        } } while (0)
    if (IN(0)) { if (PH(0)) { phase_A(p, lds, false); __syncthreads(); phase_A(p, lds, true); } if (IN(1) && PH(1)) { __syncthreads(); phase_B(p); } }
    if (IN(1) && !IN(0)) { if (PH(1)) phase_B(p); }
    if (DP(20)) { for (int i = 0; i < 10; ++i) xcd_barrier(xbar); }
    SEAM(2); if (IN(2)) { RUN_GEMMS(0, 1); if (DP(2)) RUN_GEMMS(0, 1); }
    SEAM(3); if (IN(3)) { if (PH(3)) { phase_M1(p, lds); if (DP(3)) phase_M1(p, lds); phase_D(p); } }
    SEAM(4); if (IN(4)) { if (PH(4)) { phase_M2(p, lds); __syncthreads(); phase_M3(p, lds, false, bid_() >= 128 ? bid_() - 128 : -1, 256, 128); } }
    SEAM(5); if (IN(5)) { if (PH(5)) phase_M3(p, lds, false, 256 + bid_(), 768, (int)gridDim.x); }
    SEAM(6); if (IN(6)) { RUN_GEMMS(1, 4); if (DP(6)) RUN_GEMMS(1, 4); }
    SEAM(7); if (IN(7)) { if (PH(7)) phase_attn(p, lds); if (DP(7)) phase_attn(p, lds); }
    for (int ph = (lo > 8 ? lo : 8); ph < hi; ++ph) {
        if (ph > lo) GSYNC(ph);
        int g0 = 0, g1 = 0;
        switch (ph) {
        case 8: g0 = 4; g1 = 6; break;
        case 9: g0 = 6; g1 = 7; break;
        case 10: if (PH(10)) phase_I(p); if (DP(10)) phase_I(p); break;
        case 11: g0 = 7; g1 = 8; break;
        case 12: g0 = 8; g1 = 10; break;
        case 13: if (DP(21)) phase_L(p, RA_ROWS, RB_ROWS, (const bf16_t*)(ws + WS_P0), (const bf16_t*)(ws + WS_P1), true);
                 if (PH(13)) phase_L(p, RA_ROWS, RB_ROWS, (const bf16_t*)(ws + WS_P0), (const bf16_t*)(ws + WS_P1)); g0 = 10; g1 = 11; break;
        case 14: g0 = 11; g1 = 13; break;
        case 15: if (DP(21)) phase_L(p, 0, RA_ROWS, (const bf16_t*)(ws + WS_P0), nullptr, true);
                 if (PH(15)) phase_L(p, 0, RA_ROWS, (const bf16_t*)(ws + WS_P0), nullptr); break;
        }
        RUN_GEMMS(g0, g1);
        if ((DUP >> ph) & 1) RUN_GEMMS(g0, g1);
    }
}

extern "C" void kernel_launch(void* const* d_in, const int* in_sizes, int n_in, void* d_out, int out_size, void* d_ws, size_t ws_size, hipStream_t stream) {
    static int grid = 0;
    if (grid == 0) {
        int dev = 0, cus = 0, per_cu = 0;
        hipGetDevice(&dev); hipDeviceGetAttribute(&cus, hipDeviceAttributeMultiprocessorCount, dev);
        if (hipFuncSetAttribute((const void*)fwd_kernel, hipFuncAttributeMaxDynamicSharedMemorySize, LDS_BYTES) != hipSuccess) fprintf(stderr, "kernel_launch: hipFuncSetAttribute failed\n");
        if (hipOccupancyMaxActiveBlocksPerMultiprocessor(&per_cu, (const void*)fwd_kernel, NT, LDS_BYTES) != hipSuccess || per_cu < 1) { fprintf(stderr, "kernel_launch: occupancy query says %d\n", per_cu); per_cu = 1; }
        (void)hipGetLastError();
        grid = cus * 1;
        if (n_in != 27 || ws_size < WS_END) fprintf(stderr, "kernel_launch: unexpected n_in %d / ws_size %zu\n", n_in, ws_size);
    }
    (void)hipMemsetAsync((unsigned char*)d_ws + WS_ADACNT, 0, 256, stream);
    Params p{};
    for (int i = 0; i < 27; ++i) p.in[i] = (const float*)d_in[i];
    p.out = (float*)d_out; p.ws = (unsigned char*)d_ws;
#ifndef MK_SPLIT
    p.ph_lo = 0; p.ph_hi = N_PHASES;
    void* args[] = {&p};
    hipError_t e = hipLaunchCooperativeKernel((const void*)fwd_kernel, dim3(grid), dim3(NT), args, LDS_BYTES, stream);
    if (e != hipSuccess) fprintf(stderr, "cooperative launch failed: %s (grid %d)\n", hipGetErrorString(e), grid);
#else
    for (int ph = 0; ph < N_PHASES; ++ph) { p.ph_lo = ph; p.ph_hi = ph + 1; hipLaunchKernelGGL(fwd_kernel, dim3(grid), dim3(NT), LDS_BYTES, stream, p); }
#endif
}
```

```cpp
#include <hip/hip_runtime.h>
#include <hip/hip_cooperative_groups.h>
#include <cstdio>
#include <cstdint>
#include <utility>
namespace cg = cooperative_groups;
__device__ __forceinline__ int tid_() { int t = threadIdx.x; asm volatile("" : "+v"(t)); return t; }
__device__ __forceinline__ int bid_() { int b = blockIdx.x; asm volatile("" : "+s"(b)); return b; }
template <class T> __device__ __forceinline__ T* gp_(T* q) { return (T*)(__attribute__((address_space(1))) T*)q; }
template <class T> __device__ __forceinline__ T* lp_(T* q) { return q; }
namespace pg8 {
#define PG8_LAS __attribute__((address_space(3)))
typedef unsigned short bf16_t;
typedef short bf16x8 __attribute__((ext_vector_type(8)));
typedef float f32x4 __attribute__((ext_vector_type(4)));
typedef unsigned u32x4 __attribute__((ext_vector_type(4)));
constexpr int BM = 256, BK = 64, HALF = 128, HTB = HALF * BK * 2  , STAGE_BYTES = 8 * HTB, NXCD = 8, WGM = 8;

__host__ __device__ __forceinline__ int lds_byte(int r, int c) { const int st = (r >> 4) * 2 + (c >> 5), rr = r & 15, cc = c & 31, ob = rr * 64 + cc * 2; return st * 1024 + (ob ^ (((ob >> 9) & 1) << 5)); }
__host__ __device__ __forceinline__ void stage_rc(int b, int& R, int& C) { const int st = b / 1024, sb = b % 1024, swz = sb ^ (((sb >> 9) & 1) << 5); R = (st >> 1) * 16 + swz / 64; C = (st & 1) * 32 + (swz % 64) / 2; }
__host__ __device__ __forceinline__ int perm32(int rho) { const int n = rho >> 4, i = rho & 15; return 8 * (i >> 2) + 4 * n + (i & 3); }

struct Unit { int pm, pn; };
struct Gemm { const bf16_t* A; const bf16_t* Bt; int M, N, K; };

struct StaticOrder {
    int nM, nN, nwg, G, c;
    __host__ __device__ void init(int M, int N, int G_, int c_) { nM = M / BM; nN = N / BM; nwg = nM * nN; G = G_; c = c_; }
    __host__ __device__ bool next(int i, Unit& u) const {
        const long L = (long)i * G + c; if (L >= nwg) return false;
        int wgid = (int)L; { const int q = nwg / NXCD, r = nwg % NXCD, xcd = wgid % NXCD, off = wgid / NXCD; wgid = (xcd < r ? xcd * (q + 1) : r * (q + 1) + (xcd - r) * q) + off; }
        const int nig = WGM * nN, gid = wgid / nig, fm = gid * WGM, gsz = (nM - fm) < WGM ? (nM - fm) : WGM;
        u.pm = fm + ((wgid % nig) % gsz); u.pn = (wgid % nig) / gsz; return true;
    }
    __device__ __forceinline__ void a_ready(const Unit&) const {}
    __device__ __forceinline__ void done(const Unit&) const {}
};
__device__ __forceinline__ unsigned cvt_pk_bf16(float lo, float hi) { unsigned r; asm volatile("v_cvt_pk_bf16_f32 %0, %1, %2" : "=v"(r) : "v"(lo), "v"(hi)); return r; }
template <class Epi, class Sched, bool ALIGN_EPI = false, bool SP2 = false>
__device__ __forceinline__ void gemm_phase(PG8_LAS unsigned char* lds, const Gemm g, const Sched& S, const Epi& E) {
    const int tid = tid_(), wid = __builtin_amdgcn_readfirstlane(tid >> 6), lane = tid & 63, wr = wid >> 2, wc = wid & 3, fr = lane & 15, fq = lane >> 4;
    const int K = g.K, nt = K / BK;
    unsigned voffA[2], voffB[2];
#pragma unroll
    for (int i = 0; i < 2; ++i) { int R, C; stage_rc(tid * 16 + i * 8192, R, C); const int Rb = Epi::PERM ? ((R & ~31) + perm32(R & 31)) : R;
        voffA[i] = (unsigned)(R * K + C) * 2u; voffB[i] = (unsigned)(Rb * K + C) * 2u; }
    const size_t kstep = (size_t)(BK * 2);
    const size_t hstep = (size_t)HALF * K * 2;
    const size_t tstep = 2 * hstep;
    const unsigned ldsw = (unsigned)wid * 1024u;
    const int aoff = lds_byte(wr * 64 + fr, fq * 8), boff = lds_byte(wc * 32 + fr, fq * 8);
#define PG8_SA(b, h) (((b) * 2 + (h)) * HTB)
#define PG8_SB(b, h) ((4 + (b) * 2 + (h)) * HTB)
#define PG8_STAGE(bufoff, gbase, voff) do { _Pragma("unroll") for (int _i = 0; _i < 2; ++_i) \
        __builtin_amdgcn_global_load_lds((const unsigned*)((const char*)(gbase) + (voff)[_i]), (PG8_LAS unsigned*)(lds + (bufoff) + ldsw + _i * 8192), 16, 0, 0); } while (0)
#define PG8_LDA(dst, b, h) do { _Pragma("unroll") for (int m = 0; m < 4; ++m) _Pragma("unroll") for (int k = 0; k < 2; ++k) dst[m][k] = *(const PG8_LAS bf16x8*)(lds + PG8_SA(b, h) + aoff + m * 2048 + k * 1024); } while (0)
#define PG8_LDB(dst, b, h) do { _Pragma("unroll") for (int n = 0; n < 2; ++n) _Pragma("unroll") for (int k = 0; k < 2; ++k) dst[n][k] = *(const PG8_LAS bf16x8*)(lds + PG8_SB(b, h) + boff + n * 2048 + k * 1024); } while (0)
#define PG8_MMA(ai, bj, At, Bt) do { __builtin_amdgcn_s_setprio(1); _Pragma("unroll") for (int m = 0; m < 4; ++m) _Pragma("unroll") for (int n = 0; n < 2; ++n) _Pragma("unroll") for (int k = 0; k < 2; ++k) \
        acc[ai][bj][m][n] = __builtin_amdgcn_mfma_f32_16x16x32_bf16(Bt[n][k], At[m][k], acc[ai][bj][m][n], 0, 0, 0); __builtin_amdgcn_s_setprio(0); } while (0)
#define PG8_WAIT_V(n) asm volatile("s_waitcnt vmcnt(" #n ")" ::: "memory")
#define PG8_WAIT_L(n) asm volatile("s_waitcnt lgkmcnt(" #n ")" ::: "memory")
#define PG8_BAR __builtin_amdgcn_s_barrier()
#define PG8_SCHED __builtin_amdgcn_sched_barrier(0)
    Unit cur, nxt; int ui = 0;
    if (!S.next(0, cur)) return;
    f32x4 acc[2][2][4][2];
#pragma unroll
    for (int a = 0; a < 2; ++a)
#pragma unroll
        for (int b = 0; b < 2; ++b)
#pragma unroll
            for (int m = 0; m < 4; ++m)
#pragma unroll
                for (int n = 0; n < 2; ++n) acc[a][b][m][n] = (f32x4){0.f, 0.f, 0.f, 0.f};
    bf16x8 At[4][2], B0[2][2], B1[2][2];
    const char* cA = (const char*)g.A + (size_t)cur.pm * tstep; const char* cB = (const char*)g.Bt + (size_t)cur.pn * tstep;
    S.a_ready(cur);
    if constexpr (SP2) {
        PG8_STAGE(PG8_SB(0, 0), cB, voffB); PG8_STAGE(PG8_SB(0, 1), cB + hstep, voffB); PG8_STAGE(PG8_SA(0, 0), cA, voffA); PG8_STAGE(PG8_SA(0, 1), cA + hstep, voffA);
        if (wr == 1) PG8_BAR;
        PG8_WAIT_V(2); PG8_BAR;
        PG8_STAGE(PG8_SB(1, 0), cB + kstep, voffB); PG8_STAGE(PG8_SA(1, 0), cA + kstep, voffA); PG8_STAGE(PG8_SB(1, 1), cB + hstep + kstep, voffB);
        PG8_WAIT_V(6); PG8_BAR;
    } else {
        PG8_STAGE(PG8_SB(0, 0), cB, voffB); PG8_STAGE(PG8_SA(0, 0), cA, voffA); PG8_STAGE(PG8_SB(0, 1), cB + hstep, voffB); PG8_STAGE(PG8_SA(0, 1), cA + hstep, voffA);
        if (wr == 1) PG8_BAR;
        PG8_WAIT_V(4); PG8_BAR;
        PG8_STAGE(PG8_SB(1, 0), cB + kstep, voffB); PG8_STAGE(PG8_SA(1, 0), cA + kstep, voffA); PG8_STAGE(PG8_SB(1, 1), cB + hstep + kstep, voffB);
        PG8_WAIT_V(6); PG8_BAR;
    }
    for (;;) {
        const bool has_next = S.next(ui + 1, nxt);
        const char* nA = has_next ? (const char*)g.A + (size_t)nxt.pm * tstep : cA; const char* nB = has_next ? (const char*)g.Bt + (size_t)nxt.pn * tstep : cB;
        for (int t = 0; t < nt; t += 2) {
            const bool last = (t == nt - 2);
            const char* a1 = cA + (size_t)(t + 1) * kstep;
            const char* a2 = last ? nA : cA + (size_t)(t + 2) * kstep; const char* b2 = last ? nB : cB + (size_t)(t + 2) * kstep;
            const char* a3 = a2 + kstep; const char* b3 = b2 + kstep;
            if (last && has_next) S.a_ready(nxt);
            if constexpr (SP2) {
            PG8_LDB(B0, 0, 0); PG8_LDB(B1, 0, 1); PG8_SCHED; PG8_LDA(At, 0, 0); PG8_STAGE(PG8_SA(1, 1), a1 + hstep, voffA);
            PG8_WAIT_V(8); PG8_WAIT_L(0); PG8_BAR; PG8_MMA(0, 0, At, B0); PG8_MMA(0, 1, At, B1); PG8_BAR; PG8_SCHED;
            PG8_LDA(At, 0, 1); PG8_STAGE(PG8_SB(0, 0), b2, voffB); PG8_STAGE(PG8_SB(0, 1), b2 + hstep, voffB); PG8_STAGE(PG8_SA(0, 0), a2, voffA);
            PG8_WAIT_V(8); PG8_WAIT_L(0); PG8_BAR; PG8_MMA(1, 0, At, B0); PG8_MMA(1, 1, At, B1); PG8_BAR; PG8_SCHED;
            PG8_LDB(B0, 1, 0); PG8_LDB(B1, 1, 1); PG8_SCHED; PG8_LDA(At, 1, 0); PG8_STAGE(PG8_SA(0, 1), a2 + hstep, voffA);
            PG8_WAIT_V(8); PG8_WAIT_L(0); PG8_BAR; PG8_MMA(0, 0, At, B0); PG8_MMA(0, 1, At, B1); PG8_BAR; PG8_SCHED;
            PG8_LDA(At, 1, 1); PG8_STAGE(PG8_SB(1, 0), b3, voffB); PG8_STAGE(PG8_SB(1, 1), b3 + hstep, voffB); PG8_STAGE(PG8_SA(1, 0), a3, voffA);
            PG8_WAIT_V(8); PG8_WAIT_L(0); PG8_BAR; PG8_MMA(1, 0, At, B0); PG8_MMA(1, 1, At, B1); PG8_BAR; PG8_SCHED;
            } else {
            PG8_LDB(B0, 0, 0); PG8_SCHED; PG8_LDA(At, 0, 0); PG8_STAGE(PG8_SA(1, 1), a1 + hstep, voffA);
            PG8_WAIT_L(8); PG8_BAR; PG8_WAIT_L(0); PG8_MMA(0, 0, At, B0); PG8_BAR; PG8_SCHED;
            PG8_LDB(B1, 0, 1); PG8_STAGE(PG8_SB(0, 0), b2, voffB);
            PG8_BAR; PG8_WAIT_L(0); PG8_MMA(0, 1, At, B1); PG8_BAR;
            PG8_LDA(At, 0, 1); PG8_STAGE(PG8_SA(0, 0), a2, voffA);
            PG8_BAR; PG8_WAIT_L(0); PG8_MMA(1, 0, At, B0); PG8_BAR; PG8_SCHED;
            PG8_STAGE(PG8_SB(0, 1), b2 + hstep, voffB);
            PG8_WAIT_V(6); PG8_BAR; PG8_MMA(1, 1, At, B1); PG8_BAR;
            PG8_LDB(B0, 1, 0); PG8_SCHED; PG8_LDA(At, 1, 0); PG8_STAGE(PG8_SA(0, 1), a2 + hstep, voffA);
            PG8_WAIT_L(8); PG8_BAR; PG8_WAIT_L(0); PG8_MMA(0, 0, At, B0); PG8_BAR; PG8_SCHED;
            PG8_LDB(B1, 1, 1); PG8_STAGE(PG8_SB(1, 0), b3, voffB);
            PG8_BAR; PG8_WAIT_L(0); PG8_MMA(0, 1, At, B1); PG8_BAR;
            PG8_LDA(At, 1, 1); PG8_STAGE(PG8_SA(1, 0), a3, voffA);
            PG8_BAR; PG8_WAIT_L(0); PG8_MMA(1, 0, At, B0); PG8_BAR; PG8_SCHED;
            PG8_STAGE(PG8_SB(1, 1), b3 + hstep, voffB);
            PG8_WAIT_V(6); PG8_BAR; PG8_MMA(1, 1, At, B1); PG8_BAR;
            }
        }
        if constexpr (ALIGN_EPI) { if (wr == 0) PG8_BAR; }
        if constexpr (!Epi::AFTER_DRAIN) { E(acc, cur, wr, wc, fr, fq); S.done(cur); }
        if (!has_next) break;
#pragma unroll
        for (int a = 0; a < 2; ++a)
#pragma unroll
            for (int b = 0; b < 2; ++b)
#pragma unroll
                for (int m = 0; m < 4; ++m)
#pragma unroll
                    for (int n = 0; n < 2; ++n) acc[a][b][m][n] = (f32x4){0.f, 0.f, 0.f, 0.f};
        cur = nxt; cA = nA; cB = nB; ++ui;
        if constexpr (ALIGN_EPI) { if (wr == 1) PG8_BAR; }
    }
    PG8_WAIT_V(0);
    if constexpr (!ALIGN_EPI) { if (wr == 0) PG8_BAR; }
    PG8_BAR;
    if constexpr (Epi::AFTER_DRAIN) { E.fused(acc, cur, wr, wc, fr, fq, lds, wid, lane); S.done(cur); }
#undef PG8_SA
#undef PG8_SB
#undef PG8_STAGE
#undef PG8_LDA
#undef PG8_LDB
#undef PG8_MMA
#undef PG8_WAIT_V
#undef PG8_WAIT_L
#undef PG8_BAR
#undef PG8_SCHED
}
}

typedef unsigned short bf16_t;
typedef short bf16x8 __attribute__((ext_vector_type(8)));
typedef short s16x4 __attribute__((ext_vector_type(4)));
typedef float f32x4 __attribute__((ext_vector_type(4)));
typedef float f32x16 __attribute__((ext_vector_type(16)));
typedef unsigned u32x4 __attribute__((ext_vector_type(4)));
typedef unsigned u32x2 __attribute__((ext_vector_type(2)));
#define LAS __attribute__((address_space(3)))
#define DI __device__ __forceinline__

constexpr int NT = 512;
constexpr int R = 24576, RC = 8192, RK = 26624;
constexpr int DM = 1024, NIN = 4864;
constexpr size_t MiB = 1u << 20;
constexpr size_t WS_MOD = 0;
constexpr size_t WS_ROPE = 128 * 1024;
constexpr size_t WS_SC = 256 * 1024;
constexpr size_t WS_MP = 384 * 1024;
constexpr size_t WS_ADACNT = 768 * 1024;
constexpr size_t WS_NST = 1 * MiB;
constexpr size_t WS_GATES = 6 * MiB;
constexpr size_t WS_KRRAW = 8 * MiB;
constexpr size_t WS_WIN = 11 * MiB;
constexpr size_t WS_W1 = WS_WIN + (size_t)NIN * 1024 * 2;
constexpr size_t WS_W2 = WS_W1 + 8 * MiB;
constexpr size_t WS_WOUT = WS_W2 + 8 * MiB;
constexpr size_t WS_WOA = WS_WOUT + 2 * MiB;
constexpr size_t WS_WOM = WS_WOA + 1 * MiB;
constexpr size_t WS_WUQ = WS_WOM + 1 * MiB;
constexpr size_t WS_WUK = WS_WUQ + 768 * 384 * 2;
constexpr size_t WS_WV = WS_WUK + 512 * 256 * 2;
static_assert(WS_WV + 512 * 256 * 2 <= 42 * MiB, "weights");
constexpr size_t WS_MQKV = 42 * MiB;
constexpr size_t WS_Q = 42 * MiB;
constexpr size_t WS_KN = 78 * MiB;
constexpr size_t WS_Z = 42 * MiB;
constexpr size_t WS_H2 = 208 * MiB;
constexpr size_t WS_P0 = 42 * MiB, WS_P1 = 58 * MiB;
constexpr size_t WS_F1 = 74 * MiB;
constexpr int RA_ROWS = 16384, RB_ROWS = 8192;
constexpr size_t WS_MO = 114 * MiB;
constexpr size_t WS_MG = 138 * MiB;
constexpr size_t WS_CQ = 234 * MiB;
constexpr size_t WS_KR = 252 * MiB;
constexpr size_t WS_END = 256 * MiB;
constexpr size_t DO_H1 = 0;
constexpr size_t DO_SLOT = 0;
constexpr size_t DO_VT = 0;
constexpr size_t DO_AO = 26 * MiB;
constexpr size_t DO_CKV = 48 * MiB;
constexpr size_t DO_KC = 60 * MiB;
constexpr size_t OUT_CKV = 25165824, OUT_KROPE = 27262976, OUT_C = 27525120, OUT_N = 31719424, OUT_M = 31752192;

struct Params {
    const float* in[27];
    float* out; unsigned char* ws;
    int ph_lo, ph_hi;
};

DI unsigned pk2(float lo, float hi) { unsigned r; asm volatile("v_cvt_pk_bf16_f32 %0, %1, %2" : "=v"(r) : "v"(lo), "v"(hi)); return r; }
DI float bflo(unsigned u) { return __uint_as_float(u << 16); }
DI float bfhi(unsigned u) { return __uint_as_float(u & 0xffff0000u); }
DI float bf1(bf16_t u) { return __uint_as_float(((unsigned)u) << 16); }
DI float sigmoidf_(float x) { return __builtin_amdgcn_rcpf(1.f + __expf(-x)); }
DI float wave_sum(float v) {
#pragma unroll
    for (int o = 1; o < 64; o <<= 1) v += __shfl_xor(v, o);
    return v;
}
DI float wave_max(float v) {
#pragma unroll
    for (int o = 1; o < 64; o <<= 1) v = fmaxf(v, __shfl_xor(v, o));
    return v;
}
DI int crow(int reg, int h) { return (reg & 3) + 8 * (reg >> 2) + 4 * h; }
DI s16x4 tr_read(const LAS char* p) { return __builtin_bit_cast(s16x4, __builtin_amdgcn_ds_read_tr16_b64_v4i16((LAS s16x4*)p)); }
DI bf16x8 cat4(s16x4 a, s16x4 b) { bf16x8 r; r[0] = a[0]; r[1] = a[1]; r[2] = a[2]; r[3] = a[3]; r[4] = b[0]; r[5] = b[1]; r[6] = b[2]; r[7] = b[3]; return r; }
#define MFMA32(a, b, c) __builtin_amdgcn_mfma_f32_32x32x16_bf16((a), (b), (c), 0, 0, 0)
DI bf16x8 pack8(const f32x16& x, int s) {
    u32x4 p; p[0] = pk2(x[8 * s], x[8 * s + 1]); p[1] = pk2(x[8 * s + 2], x[8 * s + 3]); p[2] = pk2(x[8 * s + 4], x[8 * s + 5]); p[3] = pk2(x[8 * s + 6], x[8 * s + 7]);
    return __builtin_bit_cast(bf16x8, p);
}

enum { EM_IN = 0, EM_Q, EM_BF16, EM_G1, EM_G2, EM_F32, EM_RELU2, EM_ADD };
struct EpiGen {
    static constexpr bool PERM = true, AFTER_DRAIN = false;
    int mode; int ldc; size_t hstride;
    void* out;
    unsigned char* ws; float* dout; const float* gate_b;
    DI void st8bf(bf16_t* p, f32x4 a, f32x4 b) const { u32x4 w; w.x = pk2(a[0], a[1]); w.y = pk2(a[2], a[3]); w.z = pk2(b[0], b[1]); w.w = pk2(b[2], b[3]); *(u32x4*)p = w; }
    template <int MODE> DI void one(int row, int col, int pn, f32x4 v0, f32x4 v1) const {
        switch (MODE) {
        case EM_IN: {
            if (pn < 6) {
                const float sc = pn < 2 ? 0.08838834764831845f : 1.f;
                st8bf((bf16_t*)(ws + WS_MQKV) + (size_t)row * 1536 + col, v0 * sc, v1 * sc);
            } else if (pn < 8) {
#pragma unroll
                for (int e = 0; e < 4; ++e) { v0[e] = sigmoidf_(v0[e]); v1[e] = sigmoidf_(v1[e]); }
                st8bf((bf16_t*)(ws + WS_MO) + (size_t)row * 512 + (col - 1536), v0, v1);
            } else if (pn < 11) {
                const int cl = col - 2048;
                if (cl < 384) st8bf((bf16_t*)(ws + WS_CQ) + (size_t)row * 384 + cl, v0, v1);
                else if (cl < 416) { float* d = (float*)(ws + WS_KRRAW) + (size_t)row * 32 + (cl - 384); *(f32x4*)d = v0; *(f32x4*)(d + 4) = v1; }
                else if (cl < 432) {
                    const int gi = cl - 416; f32x4 bi = *(const f32x4*)(gate_b + gi), bfv = *(const f32x4*)(gate_b + gi + 4);
                    f32x4 li = v0 + bi, x = v1 + bfv, lf;
#pragma unroll
                    for (int e = 0; e < 4; ++e) lf[e] = x[e] < -20.f ? x[e] : -__logf(1.f + __expf(-x[e]));
                    float* d = (float*)(ws + WS_GATES) + (size_t)row * 16 + gi; *(f32x4*)d = li; *(f32x4*)(d + 4) = lf;
                } else if (cl < 512) { }
                else st8bf((bf16_t*)((unsigned char*)dout + DO_CKV) + (size_t)row * 256 + (cl - 512), v0, v1);
            } else {
#pragma unroll
                for (int e = 0; e < 4; ++e) { v0[e] = sigmoidf_(v0[e]); v1[e] = sigmoidf_(v1[e]); }
                st8bf((bf16_t*)(ws + WS_MG) + (size_t)row * 2048 + (col - 2816), v0, v1);
            }
        } break;
        case EM_Q: {
            const float sc = 0.10206207261596577f * 1.4426950408889634f;
            const int d = col % 96;
            if (row >= RC && d >= 64) {
                const int t = (row - RC) & 4095, pi0 = (d - 64) >> 1;
                const int pos = pi0 < 8 ? (t >> 6) : (t & 63);
                const float* ct = (const float*)(ws + WS_ROPE) + pos * 8 + (pi0 & 7); const float* stb = ct + 512;
                const f32x4 c = *(const f32x4*)ct, s = *(const f32x4*)stb;
                f32x4 a, b;
                a[0] = v0[0] * c[0] - v0[1] * s[0]; a[1] = v0[0] * s[0] + v0[1] * c[0];
                a[2] = v0[2] * c[1] - v0[3] * s[1]; a[3] = v0[2] * s[1] + v0[3] * c[1];
                b[0] = v1[0] * c[2] - v1[1] * s[2]; b[1] = v1[0] * s[2] + v1[1] * c[2];
                b[2] = v1[2] * c[3] - v1[3] * s[3]; b[3] = v1[2] * s[3] + v1[3] * c[3];
                v0 = a; v1 = b;
            }
            st8bf((bf16_t*)out + (size_t)row * 768 + col, v0 * sc, v1 * sc);
        } break;
        case EM_BF16: st8bf((bf16_t*)out + (size_t)row * ldc + col, v0, v1); break;
        case EM_G1: {
            const u32x4 g = *(const u32x4*)((const bf16_t*)(ws + WS_MG) + (size_t)row * 2048 + col);
            f32x4 a, b; a[0] = v0[0] * bflo(g.x); a[1] = v0[1] * bfhi(g.x); a[2] = v0[2] * bflo(g.y); a[3] = v0[3] * bfhi(g.y);
            b[0] = v1[0] * bflo(g.z); b[1] = v1[1] * bfhi(g.z); b[2] = v1[2] * bflo(g.w); b[3] = v1[3] * bfhi(g.w);
            st8bf((bf16_t*)out + (size_t)row * 1024 + col, a, b);
        } break;
        case EM_G2: {
            const u32x4 g = *(const u32x4*)((const bf16_t*)(ws + WS_MG) + (size_t)row * 2048 + 1024 + col);
            const u32x4 z = *(const u32x4*)((const bf16_t*)out + (size_t)row * 1024 + col);
            f32x4 a, b; a[0] = bflo(z.x) + v0[0] * bflo(g.x); a[1] = bfhi(z.x) + v0[1] * bfhi(g.x); a[2] = bflo(z.y) + v0[2] * bflo(g.y); a[3] = bfhi(z.y) + v0[3] * bfhi(g.y);
            b[0] = bflo(z.z) + v1[0] * bflo(g.z); b[1] = bfhi(z.z) + v1[1] * bfhi(g.z); b[2] = bflo(z.w) + v1[2] * bflo(g.w); b[3] = bfhi(z.w) + v1[3] * bfhi(g.w);
            st8bf((bf16_t*)out + (size_t)row * 1024 + col, a, b);
        } break;
        case EM_F32: { float* d = (float*)out + (size_t)row * ldc + col; *(f32x4*)d = v0; *(f32x4*)(d + 4) = v1; } break;
        case EM_RELU2: {
#pragma unroll
            for (int e = 0; e < 4; ++e) { const float a = v0[e] > 0.f ? v0[e] : 0.f, b = v1[e] > 0.f ? v1[e] : 0.f; v0[e] = a * a; v1[e] = b * b; }
            st8bf((bf16_t*)out + (size_t)(col >> 11) * hstride + (size_t)row * 2048 + (col & 2047), v0, v1);
        } break;
        case EM_ADD: {
            bf16_t* d = (bf16_t*)out + (size_t)row * ldc + col; const u32x4 z = *(const u32x4*)d;
            f32x4 a, b; a[0] = bflo(z.x) + v0[0]; a[1] = bfhi(z.x) + v0[1]; a[2] = bflo(z.y) + v0[2]; a[3] = bfhi(z.y) + v0[3];
            b[0] = bflo(z.z) + v1[0]; b[1] = bfhi(z.z) + v1[1]; b[2] = bflo(z.w) + v1[2]; b[3] = bfhi(z.w) + v1[3];
            st8bf(d, a, b);
        } break;
        }
    }
    template <int MODE, int I> DI void step(const f32x4 (&acc)[2][2][4][2], const pg8::Unit& u, int wr, int wc, int fr, int fq) const {
        constexpr int ai = I >> 3, m = (I >> 1) & 3, bj = I & 1;
        one<MODE>(u.pm * 256 + ai * 128 + wr * 64 + m * 16 + fr, u.pn * 256 + bj * 128 + wc * 32 + 8 * fq, u.pn, acc[ai][bj][m][0], acc[ai][bj][m][1]);
    }
    template <int MODE, int... Is> DI void runseq(std::integer_sequence<int, Is...>, const f32x4 (&acc)[2][2][4][2], const pg8::Unit& u, int wr, int wc, int fr, int fq) const {
        (step<MODE, Is>(acc, u, wr, wc, fr, fq), ...);
    }
    template <int MODE> DI void run(const f32x4 (&acc)[2][2][4][2], const pg8::Unit& u, int wr, int wc, int fr, int fq) const {
        runseq<MODE>(std::make_integer_sequence<int, 16>{}, acc, u, wr, wc, fr, fq);
    }
    DI void operator()(const f32x4 (&acc)[2][2][4][2], const pg8::Unit& u, int wr, int wc, int fr, int fq) const {
        switch (mode) {
        case EM_IN: run<EM_IN>(acc, u, wr, wc, fr, fq); break;
        case EM_Q: run<EM_Q>(acc, u, wr, wc, fr, fq); break;
        case EM_BF16: run<EM_BF16>(acc, u, wr, wc, fr, fq); break;
        case EM_G1: run<EM_G1>(acc, u, wr, wc, fr, fq); break;
        case EM_G2: run<EM_G2>(acc, u, wr, wc, fr, fq); break;
        case EM_F32: run<EM_F32>(acc, u, wr, wc, fr, fq); break;
        case EM_ADD: run<EM_ADD>(acc, u, wr, wc, fr, fq); break;
        default: run<EM_RELU2>(acc, u, wr, wc, fr, fq); break;
        }
    }
};

DI int win_src(int n) {
    if (n < 2048) return n;
    if (n < 2432) return n + 16;
    if (n < 2464) return n - 2432 + 2704;
    if (n < 2480) return n - 2464 + 2048;
    if (n < 2560) return -1;
    if (n < 2816) return n - 2560 + 2448;
    return n - 2816 + 2736;
}
DI void transpose_item(const float* __restrict__ W, int K, int Nsrc, bf16_t* WT, int nblk, int mode, float* scr, int item, int lane) {
    const int kb = item / nblk, nb = item % nblk, k0 = 64 * kb, n0 = 32 * nb;
    const int nd = n0 + (lane & 31);
    int src = nd;
    if (mode == 1) src = win_src(nd); else if (mode == 2) src = (nd >> 6) * 128 + (nd & 63); else if (mode == 3) src = (nd >> 6) * 128 + 64 + (nd & 63);
#pragma unroll 8
    for (int i = 0; i < 32; ++i) { const int kk = 2 * i + (lane >> 5); scr[kk * 33 + (lane & 31)] = src >= 0 ? W[(size_t)(k0 + kk) * Nsrc + src] : 0.f; }
    asm volatile("s_waitcnt lgkmcnt(0)" ::: "memory"); asm volatile("" ::: "memory");
    const int c = lane & 7;
#pragma unroll
    for (int j = 0; j < 4; ++j) { const int n = (lane >> 3) + 8 * j; const float* s = scr + (8 * c) * 33 + n;
        u32x4 o; o.x = pk2(s[0 * 33], s[1 * 33]); o.y = pk2(s[2 * 33], s[3 * 33]); o.z = pk2(s[4 * 33], s[5 * 33]); o.w = pk2(s[6 * 33], s[7 * 33]);
        *(u32x4*)(WT + (size_t)(n0 + n) * K + k0 + 8 * c) = o; }
    asm volatile("s_waitcnt lgkmcnt(0)" ::: "memory"); asm volatile("" ::: "memory");
}
DI void phase_A(const Params& p, unsigned char* lds, const bool late) {
    const int tid = tid_(), lane = tid & 63, wave = tid >> 6;
    unsigned char* ws = lp_(p.ws);
    if (late) { }
    else if (bid_() < 192) {
        float* red = (float*)lds;
        float* sl = (float*)lds + 16 * 5 * 32;
        const float* wa = p.in[9]; const float* cl = p.in[7]; const float* cc = p.in[8];
        for (int e = tid; e < 5 * 1024; e += NT) { const float c = e < 1024 ? cc[e] : cl[e - 1024]; sl[e] = c * sigmoidf_(c); }
        __syncthreads();
        const int col = tid & 31, kg = tid >> 5, n0 = bid_() * 32;
        float acc[5] = {0.f, 0.f, 0.f, 0.f, 0.f};
        for (int k0 = kg; k0 < 1024; k0 += 16 * 8) {
            float w[8];
#pragma unroll
            for (int q = 0; q < 8; ++q) w[q] = wa[(size_t)(k0 + 16 * q) * 6144 + n0 + col];
#pragma unroll
            for (int q = 0; q < 8; ++q)
#pragma unroll
                for (int v = 0; v < 5; ++v) acc[v] += sl[v * 1024 + k0 + 16 * q] * w[q];
        }
#pragma unroll
        for (int v = 0; v < 5; ++v) red[(kg * 5 + v) * 32 + col] = acc[v];
        __syncthreads();
        if (tid < 160) { const int v = tid >> 5, c = tid & 31; float s = 0.f;
            for (int g = 0; g < 16; ++g) s += red[(g * 5 + v) * 32 + c];
            __hip_atomic_store((float*)(ws + WS_MOD) + v * 6144 + n0 + c, s + p.in[10][n0 + c], __ATOMIC_RELAXED, __HIP_MEMORY_SCOPE_AGENT); }
        asm volatile("s_waitcnt vmcnt(0)" ::: "memory");
        __syncthreads();
        if (tid == 0) __hip_atomic_fetch_add((unsigned*)(ws + WS_ADACNT), 1u, __ATOMIC_RELAXED, __HIP_MEMORY_SCOPE_AGENT);
    } else if (bid_() == 255) {
        const int pos = tid >> 3, j = tid & 7;
        double inv = 1.0; for (int i = 0; i < j; ++i) inv *= 0.31622776601683794;
        const double x = (double)pos * inv;
        const double kq = rint(x * 0.6366197723675814); const double r = x - kq * 1.5707963267948966, r2 = r * r;
        const double sn = r * (1.0 + r2 * (-1.0 / 6 + r2 * (1.0 / 120 + r2 * (-1.0 / 5040 + r2 * (1.0 / 362880 + r2 * (-1.0 / 39916800 + r2 * (1.0 / 6227020800.0)))))));
        const double cs = 1.0 + r2 * (-0.5 + r2 * (1.0 / 24 + r2 * (-1.0 / 720 + r2 * (1.0 / 40320 + r2 * (-1.0 / 3628800 + r2 * (1.0 / 479001600.0))))));
        const int q = ((int)kq) & 3;
        const double cv = q == 0 ? cs : (q == 1 ? -sn : (q == 2 ? -cs : sn));
        const double sv = q == 0 ? sn : (q == 1 ? cs : (q == 2 ? -sn : -cs));
        float* T = (float*)(ws + WS_ROPE); T[pos * 8 + j] = (float)cv; T[512 + pos * 8 + j] = (float)sv;
    }
    float* scr = (float*)lds + wave * (64 * 33);
    const int gw = bid_() * 8 + wave, NGW = gridDim.x * 8;
    constexpr int I0 = 16 * 152, I1 = 6 * 24, I2 = 4 * 16, I3 = 4 * 16, I4 = 8 * 32, I5 = 8 * 32, I6 = 16 * 32, I7 = 16 * 128, I8 = 64 * 32;
    constexpr int NITEMS = I0 + I1 + I2 + I3 + I4 + I5 + I6 + I7 + I8;
    for (int it = late ? I0 + gw : gw; it < (late ? NITEMS : I0); it += NGW) {
        int r = it;
        if (r < I0) { transpose_item(p.in[15], 1024, 4784, (bf16_t*)(ws + WS_WIN), 152, 1, scr, r, lane); continue; } r -= I0;
        if (r < I1) { transpose_item(p.in[19], 384, 768, (bf16_t*)(ws + WS_WUQ), 24, 0, scr, r, lane); continue; } r -= I1;
        if (r < I2) { transpose_item(p.in[20], 256, 1024, (bf16_t*)(ws + WS_WUK), 16, 2, scr, r, lane); continue; } r -= I2;
        if (r < I3) { transpose_item(p.in[20], 256, 1024, (bf16_t*)(ws + WS_WV), 16, 3, scr, r, lane); continue; } r -= I3;
        if (r < I4) { transpose_item(p.in[21], 512, 1024, (bf16_t*)(ws + WS_WOA), 32, 0, scr, r, lane); continue; } r -= I4;
        if (r < I5) { transpose_item(p.in[23], 512, 1024, (bf16_t*)(ws + WS_WOM), 32, 0, scr, r, lane); continue; } r -= I5;
        if (r < I6) { transpose_item(p.in[24], 1024, 1024, (bf16_t*)(ws + WS_WOUT), 32, 0, scr, r, lane); continue; } r -= I6;
        if (r < I7) { transpose_item(p.in[25], 1024, 4096, (bf16_t*)(ws + WS_W1), 128, 0, scr, r, lane); continue; } r -= I7;
        if (r < 1024) transpose_item(p.in[26], 2048, 1024, (bf16_t*)(ws + WS_W2), 32, 0, scr, r, lane);
        else transpose_item(p.in[26] + (size_t)2048 * 1024, 2048, 1024, (bf16_t*)(ws + WS_W2) + (size_t)1024 * 2048, 32, 0, scr, r - 1024, lane);
    }
}

DI const float* xrow_ptr(const Params& p, int row) { return row < RC ? p.in[0] + (size_t)row * DM : p.in[1] + (size_t)(row - RC) * DM; }
DI int row_group(int row) { return row < RC ? 0 : 1 + ((row - RC) >> 12); }
DI float ssq4(const f32x4& v) { return (v.x * v.x + v.y * v.y) + (v.z * v.z + v.w * v.w); }
DI void phase_B(const Params& p) {
    constexpr int NR = 4;
    {
        if (tid_() == 0) { unsigned* c = (unsigned*)(lp_(p.ws) + WS_ADACNT); while (__hip_atomic_load(c, __ATOMIC_RELAXED, __HIP_MEMORY_SCOPE_AGENT) < 192u) __builtin_amdgcn_s_sleep(2);
            __builtin_amdgcn_fence(__ATOMIC_ACQUIRE, "agent"); asm volatile("s_waitcnt vmcnt(0)" ::: "memory"); }
        __syncthreads();
    }
    const int lane = tid_() & 63, gw = bid_() * 8 + (tid_() >> 6), NGW = gridDim.x * 8;
    const float* mod = (const float*)(lp_(p.ws) + WS_MOD); const float* nw = p.in[11];
    bf16_t* H1 = (bf16_t*)((unsigned char*)p.out + DO_H1);
    for (int row0 = gw * NR; row0 < R; row0 += NGW * NR) {
        f32x4 v[NR][4]; float s[NR];
#pragma unroll
        for (int r = 0; r < NR; ++r) { const f32x4* xr = (const f32x4*)xrow_ptr(p, row0 + r) + lane;
#pragma unroll
            for (int j = 0; j < 4; ++j) v[r][j] = xr[64 * j]; }
#pragma unroll
        for (int r = 0; r < NR; ++r) { s[r] = 0.f;
#pragma unroll
            for (int j = 0; j < 4; ++j) s[r] += ssq4(v[r][j]);
            s[r] = rsqrtf(wave_sum(s[r]) * (1.f / DM) + 1e-6f); }
        const float* mv = mod + row_group(row0) * 6144;
#pragma unroll
        for (int j = 0; j < 4; ++j) { const int c = 4 * lane + 256 * j;
            const f32x4 w = *(const f32x4*)(nw + c), sh = *(const f32x4*)(mv + c), sc = *(const f32x4*)(mv + 1024 + c);
#pragma unroll
            for (int r = 0; r < NR; ++r) { const f32x4 h = v[r][j] * s[r] * w * (sc + 1.f) + sh;
                u32x2 o; o.x = pk2(h.x, h.y); o.y = pk2(h.z, h.w); *(u32x2*)(H1 + (size_t)(row0 + r) * DM + c) = o; } }
    }
}
DI void phase_I(const Params& p) {
    constexpr int NR = 4;
    const int lane = tid_() & 63, gw = bid_() * 8 + (tid_() >> 6), NGW = gridDim.x * 8;
    const float* mod = (const float*)(lp_(p.ws) + WS_MOD); const float* post1 = p.in[12]; const float* pre2 = p.in[13];
    const bf16_t* MIX = (const bf16_t*)(p.ws + WS_MG); bf16_t* H2 = (bf16_t*)(p.ws + WS_H2);
    for (int row0 = gw * NR; row0 < R; row0 += NGW * NR) {
        f32x4 x[NR][4], m[NR][4]; float rs[NR], rstd[NR];
#pragma unroll
        for (int r = 0; r < NR; ++r) { const f32x4* xr = (const f32x4*)xrow_ptr(p, row0 + r) + lane; const u32x2* mr = (const u32x2*)(MIX + (size_t)(row0 + r) * DM) + lane;
#pragma unroll
            for (int j = 0; j < 4; ++j) { x[r][j] = xr[64 * j]; const u32x2 mm = mr[64 * j]; m[r][j].x = bflo(mm.x); m[r][j].y = bfhi(mm.x); m[r][j].z = bflo(mm.y); m[r][j].w = bfhi(mm.y); } }
#pragma unroll
        for (int r = 0; r < NR; ++r) { float s = 0.f;
#pragma unroll
            for (int j = 0; j < 4; ++j) s += ssq4(m[r][j]);
            rs[r] = rsqrtf(wave_sum(s) * (1.f / DM) + 1e-6f); }
        const float* mv = mod + row_group(row0) * 6144;
#pragma unroll
        for (int r = 0; r < NR; ++r) rstd[r] = 0.f;
#pragma unroll
        for (int j = 0; j < 4; ++j) { const int c = 4 * lane + 256 * j;
            const f32x4 w = *(const f32x4*)(post1 + c), g = *(const f32x4*)(mv + 2048 + c);
#pragma unroll
            for (int r = 0; r < NR; ++r) { x[r][j] = x[r][j] + g * (m[r][j] * rs[r] * w);
                *(f32x4*)(p.out + (size_t)(row0 + r) * DM + c) = x[r][j]; rstd[r] += ssq4(x[r][j]); } }
#pragma unroll
        for (int r = 0; r < NR; ++r) rstd[r] = rsqrtf(wave_sum(rstd[r]) * (1.f / DM) + 1e-6f);
#pragma unroll
        for (int j = 0; j < 4; ++j) { const int c = 4 * lane + 256 * j;
            const f32x4 w = *(const f32x4*)(pre2 + c), sh = *(const f32x4*)(mv + 3072 + c), sc = *(const f32x4*)(mv + 4096 + c);
#pragma unroll
            for (int r = 0; r < NR; ++r) { const f32x4 h = x[r][j] * rstd[r] * w * (sc + 1.f) + sh;
                u32x2 o; o.x = pk2(h.x, h.y); o.y = pk2(h.z, h.w); *(u32x2*)(H2 + (size_t)(row0 + r) * DM + c) = o; } }
    }
}
DI void phase_L(const Params& p, int row_start, int nrows, const bf16_t* F0, const bf16_t* F1, bool dry = false) {
    constexpr int NR = 4;
    const int lane = tid_() & 63, gw = bid_() * 8 + (tid_() >> 6), NGW = gridDim.x * 8;
    const float* mod = (const float*)(lp_(p.ws) + WS_MOD); const float* post2 = p.in[14];
    for (int rl0 = gw * NR; rl0 < nrows; rl0 += NGW * NR) {
        f32x4 f[NR][4], y[NR][4]; float rs[NR];
#pragma unroll
        for (int r = 0; r < NR; ++r) { const u32x2* fr = (const u32x2*)(F0 + (size_t)(rl0 + r) * DM) + lane; const f32x4* yr = (const f32x4*)(p.out + (size_t)(row_start + rl0 + r) * DM) + lane;
#pragma unroll
            for (int j = 0; j < 4; ++j) { const u32x2 ff = fr[64 * j]; f[r][j].x = bflo(ff.x); f[r][j].y = bfhi(ff.x); f[r][j].z = bflo(ff.y); f[r][j].w = bfhi(ff.y); y[r][j] = yr[64 * j]; }
            if (F1) { const u32x2* gr = (const u32x2*)(F1 + (size_t)(rl0 + r) * DM) + lane;
#pragma unroll
                for (int j = 0; j < 4; ++j) { const u32x2 ff = gr[64 * j]; f[r][j].x += bflo(ff.x); f[r][j].y += bfhi(ff.x); f[r][j].z += bflo(ff.y); f[r][j].w += bfhi(ff.y); } } }
#pragma unroll
        for (int r = 0; r < NR; ++r) { float s = 0.f;
#pragma unroll
            for (int j = 0; j < 4; ++j) s += ssq4(f[r][j]);
            rs[r] = rsqrtf(wave_sum(s) * (1.f / DM) + 1e-6f); }
        const float* mv = mod + row_group(row_start + rl0) * 6144;
#pragma unroll
        for (int j = 0; j < 4; ++j) { const int c = 4 * lane + 256 * j;
            const f32x4 w = *(const f32x4*)(post2 + c), g = *(const f32x4*)(mv + 5120 + c);
#pragma unroll
            for (int r = 0; r < NR; ++r) if (!dry || rs[r] == 12345.678f) *(f32x4*)(p.out + (size_t)(row_start + rl0 + r) * DM + c) = y[r][j] + g * (f[r][j] * rs[r] * w); }
    }
}
DI int key_row(int row) { return row < RC ? row : RC + ((row - RC) >> 12) * 4608 + ((row - RC) & 4095); }
DI void phase_D(const Params& p) {
    constexpr int NR = 4;
    const int tid = tid_(), lane = tid & 63, gw = bid_() * 8 + (tid >> 6), NGW = gridDim.x * 8, gt = bid_() * NT + tid, NGT = gridDim.x * NT;
    unsigned char* ws = lp_(p.ws); unsigned char* dob = (unsigned char*)p.out;
    bf16_t* CQ = (bf16_t*)(ws + WS_CQ); const bf16_t* CKV = (const bf16_t*)(dob + DO_CKV); const float* KRR = (const float*)(ws + WS_KRRAW);
    bf16_t* KC = (bf16_t*)(dob + DO_KC); bf16_t* KR = (bf16_t*)(ws + WS_KR); const float* RT = (const float*)(ws + WS_ROPE);
    const float* qn = p.in[17]; const float* kvn = p.in[18];
    for (int row0 = gw * NR; row0 < R; row0 += NGW * NR) {
        unsigned u[NR][3]; u32x2 kv[NR];
#pragma unroll
        for (int r = 0; r < NR; ++r) { const unsigned* cq = (const unsigned*)(CQ + (size_t)(row0 + r) * 384);
#pragma unroll
            for (int j = 0; j < 3; ++j) u[r][j] = cq[lane + 64 * j];
            kv[r] = *(const u32x2*)(CKV + (size_t)(row0 + r) * 256 + 4 * lane); }
#pragma unroll
        for (int r = 0; r < NR; ++r) { const int row = row0 + r; float s = 0.f;
#pragma unroll
            for (int j = 0; j < 3; ++j) { const float a = bflo(u[r][j]), b = bfhi(u[r][j]); s += a * a + b * b; }
            const float rq = rsqrtf(wave_sum(s) * (1.f / 384) + 1e-6f);
            unsigned* cq = (unsigned*)(CQ + (size_t)row * 384);
#pragma unroll
            for (int j = 0; j < 3; ++j) { const int c = 2 * (lane + 64 * j); cq[lane + 64 * j] = pk2(bflo(u[r][j]) * rq * qn[c], bfhi(u[r][j]) * rq * qn[c + 1]); }
            f32x4 v; v.x = bflo(kv[r].x); v.y = bfhi(kv[r].x); v.z = bflo(kv[r].y); v.w = bfhi(kv[r].y);
            const float rk = rsqrtf(wave_sum(ssq4(v)) * (1.f / 256) + 1e-6f);
            v = v * rk * *(const f32x4*)(kvn + 4 * lane);
            u32x2 o; o.x = pk2(v.x, v.y); o.y = pk2(v.z, v.w); *(u32x2*)(KC + (size_t)key_row(row) * 256 + 4 * lane) = o;
            if (row < RC) *(f32x4*)(p.out + OUT_CKV + (size_t)row * 256 + 4 * lane) = v; }
    }
    for (int e = gt; e < R * 16; e += NGT) { const int row = e >> 4, pi = e & 15;
        const float x1 = KRR[(size_t)row * 32 + 2 * pi], x2 = KRR[(size_t)row * 32 + 2 * pi + 1]; float o1 = x1, o2 = x2;
        if (row < RC) { p.out[OUT_KROPE + (size_t)row * 32 + 2 * pi] = x1; p.out[OUT_KROPE + (size_t)row * 32 + 2 * pi + 1] = x2; }
        else { const int t = (row - RC) & 4095, pos = pi < 8 ? (t >> 6) : (t & 63); const float c = RT[pos * 8 + (pi & 7)], sn = RT[512 + pos * 8 + (pi & 7)];
            o1 = x1 * c - x2 * sn; o2 = x1 * sn + x2 * c; }
        *(unsigned*)(KR + (size_t)key_row(row) * 32 + 2 * pi) = pk2(o1, o2); }
    for (int e = gt; e < 2048 * 64; e += NGT) { const int j2 = e >> 6, c4 = e & 63, b = j2 >> 9, j = j2 & 511, kr = RC + b * 4608 + 4096 + j;
        const f32x4 v = *(const f32x4*)(p.in[2] + (size_t)j2 * 256 + 4 * c4);
        u32x2 o; o.x = pk2(v.x, v.y); o.y = pk2(v.z, v.w); *(u32x2*)(KC + (size_t)kr * 256 + 4 * c4) = o; }
    for (int e = gt; e < 2048 * 16; e += NGT) { const int j2 = e >> 4, pi = e & 15, b = j2 >> 9, j = j2 & 511, kr = RC + b * 4608 + 4096 + j;
        *(unsigned*)(KR + (size_t)kr * 32 + 2 * pi) = pk2(p.in[3][(size_t)j2 * 32 + 2 * pi], p.in[3][(size_t)j2 * 32 + 2 * pi + 1]); }
}

constexpr int KT_STR = 320;
constexpr int KR_STR = 272;
DI void scan_add2(float x0, float x1, float& b0, float& b1, int lane) {
    float s = x0 + x1;
#pragma unroll
    for (int o = 1; o < 64; o <<= 1) { const float t = __shfl_up(s, o); if (lane >= o) s += t; }
    b1 = s; b0 = s - x1;
}
DI void scan_max2(float x0, float x1, float& m0, float& m1, int lane) {
    float s = fmaxf(x0, x1);
#pragma unroll
    for (int o = 1; o < 64; o <<= 1) { const float t = __shfl_up(s, o); if (lane >= o) s = fmaxf(s, t); }
    m1 = s; const float prev = __shfl_up(s, 1); m0 = lane > 0 ? fmaxf(prev, x0) : x0;
}
DI int tr_off(int lane, int r0, int c0) { const int i = lane & 15; return (r0 + (i >> 2)) * KT_STR + (c0 + 4 * (i & 3)) * 2; }

DI void phase_M1(const Params& p, unsigned char* lds) {
    const int tid = tid_(), lane = tid & 63, wave = tid >> 6, hh = lane >> 5, g1 = (lane >> 4) & 1;
    unsigned char* ws = lp_(p.ws);
    const bf16_t* MQKV = (const bf16_t*)(ws + WS_MQKV); const float* GATES = (const float*)(ws + WS_GATES);
    bf16_t* SLOT = (bf16_t*)((unsigned char*)p.out + DO_SLOT); float* NST = (float*)(ws + WS_NST); float* SC = (float*)(ws + WS_SC);
    unsigned char* Kt = lds; unsigned char* Vt = lds + 128 * KT_STR; float* wbuf = (float*)(lds + 2 * 128 * KT_STR);
    const LAS char* Kt3 = (const LAS char*)Kt; const LAS char* Vt3 = (const LAS char*)Vt;
#define M1_DECODE(u_, slot_, rowbase_, h_, d_) do { \
        if ((u_) < 512) { const int c = (u_) >> 1, k = (u_) & 1; d_ = c & 1; h_ = (c >> 1) & 3; const int s = c >> 3; rowbase_ = s * 256 + (d_ ? 1 - k : k) * 128; slot_ = 2 * c + k; } \
        else { const int v = (u_) - 512, lc = v / 31, k = v % 31; d_ = lc & 1; h_ = (lc >> 1) & 3; const int b = lc >> 3; rowbase_ = RC + b * 4096 + (d_ ? 31 - k : k) * 128; slot_ = 512 + 32 * lc + k + 1; } } while (0)
#define M1_LOAD(rowbase_, h_, d_) do { \
        _Pragma("unroll") for (int i = 0; i < 4; ++i) { const int id = tid + NT * i, row = id >> 4, ch = id & 15; \
            const bf16_t* src = MQKV + (size_t)((rowbase_) + row) * 1536 + (h_) * 128 + ch * 8; rk[i] = *(const u32x4*)(src + 512); rv[i] = *(const u32x4*)(src + 1024); } \
        if (wave == 0) { const int p0 = 2 * lane, p1 = p0 + 1, t0 = (d_) ? 127 - p0 : p0, t1 = (d_) ? 127 - p1 : p1; \
            gf0 = GATES[(size_t)((rowbase_) + t0) * 16 + (d_) * 8 + 4 + (h_)]; gf1 = GATES[(size_t)((rowbase_) + t1) * 16 + (d_) * 8 + 4 + (h_)]; \
            gi0 = GATES[(size_t)((rowbase_) + t0) * 16 + (d_) * 8 + (h_)]; gi1 = GATES[(size_t)((rowbase_) + t1) * 16 + (d_) * 8 + (h_)]; } } while (0)
    u32x4 rk[4], rv[4]; float gf0 = 0.f, gf1 = 0.f, gi0 = 0.f, gi1 = 0.f;
    int slot = 0, rowbase = 0, h = 0, d = 0;
    if (bid_() < 1504) { M1_DECODE(bid_(), slot, rowbase, h, d); M1_LOAD(rowbase, h, d); }
    for (int u = bid_(); u < 1504; u += gridDim.x) {
        if (wave == 0) {
            const int p0 = 2 * lane, p1 = p0 + 1, t0 = d ? 127 - p0 : p0, t1 = d ? 127 - p1 : p1;
            float b0, b1; scan_add2(gf0, gf1, b0, b1, lane);
            const float bL = __shfl(b1, 63);
            const float ga = bL - b0 + gi0, gb = bL - b1 + gi1, ml = wave_max(fmaxf(ga, gb));
            wbuf[t0] = __expf(ga - ml); wbuf[t1] = __expf(gb - ml);
            if (lane == 0) { SC[slot * 2] = bL; SC[slot * 2 + 1] = ml; }
        }
        __syncthreads();
#pragma unroll
        for (int i = 0; i < 4; ++i) { const int id = tid + NT * i, row = id >> 4, ch = id & 15;
            const u32x4 kv = rk[i]; const float w = wbuf[row];
            u32x4 ko; ko.x = pk2(bflo(kv.x) * w, bfhi(kv.x) * w); ko.y = pk2(bflo(kv.y) * w, bfhi(kv.y) * w); ko.z = pk2(bflo(kv.z) * w, bfhi(kv.z) * w); ko.w = pk2(bflo(kv.w) * w, bfhi(kv.w) * w);
            *(u32x4*)(Kt + row * KT_STR + ch * 16) = ko; *(u32x4*)(Vt + row * KT_STR + ch * 16) = rv[i]; }
        __syncthreads();
        const int cslot = slot;
        { const int un = u + gridDim.x; if (un < 1504) { M1_DECODE(un, slot, rowbase, h, d); M1_LOAD(rowbase, h, d); } }
        const int dvb = wave >> 1, dk0 = 2 * (wave & 1);
        f32x16 acc[2], accn[2];
#pragma unroll
        for (int e = 0; e < 16; ++e) { acc[0][e] = 0.f; acc[1][e] = 0.f; accn[0][e] = 0.f; accn[1][e] = 0.f; }
        bf16x8 ones;
#pragma unroll
        for (int e = 0; e < 8; ++e) ones[e] = (short)0x3f80;
#pragma unroll
        for (int ks = 0; ks < 8; ++ks) {
            const int r0 = 16 * ks + 8 * hh;
            const bf16x8 a = cat4(tr_read(Vt3 + tr_off(lane, r0, dvb * 32 + 16 * g1)), tr_read(Vt3 + tr_off(lane, r0 + 4, dvb * 32 + 16 * g1)));
#pragma unroll
            for (int j = 0; j < 2; ++j) {
                const bf16x8 b = cat4(tr_read(Kt3 + tr_off(lane, r0, (dk0 + j) * 32 + 16 * g1)), tr_read(Kt3 + tr_off(lane, r0 + 4, (dk0 + j) * 32 + 16 * g1)));
                acc[j] = MFMA32(a, b, acc[j]);
                if (dvb == 0) accn[j] = MFMA32(ones, b, accn[j]);
            }
        }
        bf16_t* so = SLOT + (size_t)cslot * 16384;
#pragma unroll
        for (int j = 0; j < 2; ++j)
#pragma unroll
            for (int e = 0; e < 16; ++e) so[(dvb * 32 + crow(e, hh)) * 128 + (dk0 + j) * 32 + (lane & 31)] = (bf16_t)(pk2(acc[j][e], 0.f) & 0xffffu);
        if (dvb == 0 && hh == 0) { NST[(size_t)cslot * 128 + dk0 * 32 + lane] = accn[0][0]; NST[(size_t)cslot * 128 + (dk0 + 1) * 32 + lane] = accn[1][0]; }
        __syncthreads();
    }
}

DI void phase_M2(const Params& p, unsigned char* lds) {
    const int gt = bid_() * NT + tid_();
    unsigned char* ws = lp_(p.ws);
    bf16_t* SLOT = (bf16_t*)((unsigned char*)p.out + DO_SLOT); float* NST = (float*)(ws + WS_NST); const float* SC = (const float*)(ws + WS_SC); float* MP = (float*)(ws + WS_MP);
    if (gt < 65536) {
        const int lc = gt >> 11, v = gt & 2047, dv = v >> 4, dko = v & 15, d = lc & 1, h = (lc >> 1) & 3, b = lc >> 3;
        const float* C0 = p.in[4] + (size_t)((b * 2 + d) * 4 + h) * 16384;
        float C[8];
#pragma unroll
        for (int j = 0; j < 8; ++j) C[j] = C0[(dko * 8 + j) * 128 + dv];
        float m = p.in[6][(b * 2 + d) * 4 + h];
        const int s0 = 512 + 32 * lc;
        { u32x4 o; o.x = pk2(C[0], C[1]); o.y = pk2(C[2], C[3]); o.z = pk2(C[4], C[5]); o.w = pk2(C[6], C[7]); *(u32x4*)(SLOT + (size_t)s0 * 16384 + v * 8) = o; }
        float nv[8];
        const bool isn = v < 16;
        if (isn) {
#pragma unroll
            for (int j = 0; j < 8; ++j) { nv[j] = p.in[5][((b * 2 + d) * 4 + h) * 128 + v * 8 + j]; NST[(size_t)s0 * 128 + v * 8 + j] = nv[j]; }
        }
        if (v == 0) MP[s0] = m;
        for (int k0 = 0; k0 < 31; k0 += 8) {
            u32x4 uu[8]; float bLs[8], mls[8]; float nu[8][8];
#pragma unroll
            for (int q = 0; q < 8; ++q) if (k0 + q < 31) { const int sl = s0 + k0 + q + 1;
                uu[q] = *(const u32x4*)(SLOT + (size_t)sl * 16384 + v * 8); bLs[q] = SC[sl * 2]; mls[q] = SC[sl * 2 + 1];
                if (isn) {
#pragma unroll
                    for (int jj = 0; jj < 8; ++jj) nu[q][jj] = NST[(size_t)sl * 128 + v * 8 + jj]; } }
#pragma unroll
            for (int q = 0; q < 8; ++q) if (k0 + q < 31) { const int sl = s0 + k0 + q + 1;
                const float bL = bLs[q], ml = mls[q];
                const float mn = fmaxf(bL + m, ml), dec = __expf(bL + m - mn), su = __expf(ml - mn);
                C[0] = dec * C[0] + su * bflo(uu[q].x); C[1] = dec * C[1] + su * bfhi(uu[q].x); C[2] = dec * C[2] + su * bflo(uu[q].y); C[3] = dec * C[3] + su * bfhi(uu[q].y);
                C[4] = dec * C[4] + su * bflo(uu[q].z); C[5] = dec * C[5] + su * bfhi(uu[q].z); C[6] = dec * C[6] + su * bflo(uu[q].w); C[7] = dec * C[7] + su * bfhi(uu[q].w);
                u32x4 o; o.x = pk2(C[0], C[1]); o.y = pk2(C[2], C[3]); o.z = pk2(C[4], C[5]); o.w = pk2(C[6], C[7]); *(u32x4*)(SLOT + (size_t)sl * 16384 + v * 8) = o;
                if (isn) {
#pragma unroll
                    for (int jj = 0; jj < 8; ++jj) { nv[jj] = dec * nv[jj] + su * nu[q][jj]; NST[(size_t)sl * 128 + v * 8 + jj] = nv[jj]; } }
                if (v == 0) MP[sl] = mn;
                m = mn; }
        }
    }
    if (bid_() < 128) {
        const int tid = tid_();
        float* T = (float*)lds;
        for (int c = bid_(); c < 256; c += 128) {
            const int d = c & 1, h = (c >> 1) & 3, s = c >> 3;
            const float bL1 = SC[(2 * c + 1) * 2], ml1 = SC[(2 * c + 1) * 2 + 1], ml0 = SC[(2 * c) * 2 + 1];
            const float m1 = ml0;
            const float m2 = fmaxf(bL1 + m1, ml1), dec = __expf(bL1 + m1 - m2), su = __expf(ml1 - m2);
            u32x4 u0[4], u1[4];
#pragma unroll
            for (int q = 0; q < 4; ++q) { const int v = tid + NT * q;
                u0[q] = *(const u32x4*)(SLOT + (size_t)(2 * c) * 16384 + v * 8); u1[q] = *(const u32x4*)(SLOT + (size_t)(2 * c + 1) * 16384 + v * 8); }
#pragma unroll
            for (int q = 0; q < 4; ++q) { const int v = tid + NT * q, dv = v >> 4, dk0 = (v & 15) * 8;
                T[(dk0 + 0) * 129 + dv] = dec * bflo(u0[q].x) + su * bflo(u1[q].x); T[(dk0 + 1) * 129 + dv] = dec * bfhi(u0[q].x) + su * bfhi(u1[q].x);
                T[(dk0 + 2) * 129 + dv] = dec * bflo(u0[q].y) + su * bflo(u1[q].y); T[(dk0 + 3) * 129 + dv] = dec * bfhi(u0[q].y) + su * bfhi(u1[q].y);
                T[(dk0 + 4) * 129 + dv] = dec * bflo(u0[q].z) + su * bflo(u1[q].z); T[(dk0 + 5) * 129 + dv] = dec * bfhi(u0[q].z) + su * bfhi(u1[q].z);
                T[(dk0 + 6) * 129 + dv] = dec * bflo(u0[q].w) + su * bflo(u1[q].w); T[(dk0 + 7) * 129 + dv] = dec * bfhi(u0[q].w) + su * bfhi(u1[q].w); }
            __syncthreads();
            float* oc = p.out + OUT_C + (size_t)((s * 2 + d) * 4 + h) * 16384;
#pragma unroll
            for (int q = 0; q < 8; ++q) { const int e = tid + NT * q, dk = e >> 5, dv4 = (e & 31) * 4;
                f32x4 o; o.x = T[dk * 129 + dv4]; o.y = T[dk * 129 + dv4 + 1]; o.z = T[dk * 129 + dv4 + 2]; o.w = T[dk * 129 + dv4 + 3];
                *(f32x4*)(oc + dk * 128 + dv4) = o; }
            if (tid < 128) {
                p.out[OUT_N + ((s * 2 + d) * 4 + h) * 128 + tid] = dec * NST[(size_t)(2 * c) * 128 + tid] + su * NST[(size_t)(2 * c + 1) * 128 + tid];
                if (tid == 0) { p.out[OUT_M + (s * 2 + d) * 4 + h] = m2; MP[2 * c] = m1; }
            }
            __syncthreads();
        }
    }
}

DI void phase_M3(const Params& p, unsigned char* lds, bool dry, const int u_first, const int u_end, const int u_step) {
    const int tid = tid_(), lane = tid & 63, wave = tid >> 6, hh = lane >> 5, g1 = (lane >> 4) & 1, l31 = lane & 31;
    unsigned char* ws = lp_(p.ws);
    const bf16_t* MQKV = (const bf16_t*)(ws + WS_MQKV); const float* GATES = (const float*)(ws + WS_GATES);
    const bf16_t* SLOT = (const bf16_t*)((unsigned char*)p.out + DO_SLOT); const float* NST = (const float*)(ws + WS_NST); const float* MP = (const float*)(ws + WS_MP);
    bf16_t* MO = (bf16_t*)(ws + WS_MO); const float* hn = p.in[22]; const float* SCm = (const float*)(ws + WS_SC);
    unsigned char* Kt = lds; unsigned char* Vt = lds + 128 * KR_STR;
    float* X = (float*)lds;
    float* ga = (float*)(lds + 128 * KR_STR + 128 * KT_STR);
    float* gc = ga + 256; float* gb = gc + 256; float* gn = gb + 256;
    unsigned char* Qt = lds + 128 * KR_STR + 128 * KT_STR + 4096;
    const LAS char* Kt3 = (const LAS char*)Kt; const LAS char* Vt3 = (const LAS char*)Vt; const LAS char* Qt3 = (const LAS char*)Qt;
#define M3_DECODE(u_) do { \
        if ((u_) < 256) { lat = false; oc = (u_) & 1; h = ((u_) >> 1) & 3; const int s_ = (u_) >> 3; nc = 2; rowbase = s_ * 256 + oc * 128; cbase = (s_ * 4 + h) * 2; } \
        else { lat = true; const int v_ = (u_) - 256; oc = v_ & 31; h = (v_ >> 5) & 3; const int b_ = v_ >> 7; nc = 32; rowbase = RC + b_ * 4096 + oc * 128; cbase = (b_ * 4 + h) * 2; } \
        { const int k0_ = oc, k1_ = nc - 1 - oc; sl0 = lat ? 512 + 32 * cbase + k0_ : (k0_ == 1 ? 2 * cbase : -1); sl1 = lat ? 512 + 32 * (cbase + 1) + k1_ : (k1_ == 1 ? 2 * (cbase + 1) : -1); } } while (0)
#define M3_LOAD() do { \
        _Pragma("unroll") for (int i = 0; i < 4; ++i) { const int id = tid + NT * i, row = id >> 4, ch = id & 15; \
            const bf16_t* src = MQKV + (size_t)(rowbase + row) * 1536 + h * 128 + ch * 8; rq[i] = *(const u32x4*)src; rk[i] = *(const u32x4*)(src + 512); rv[i] = *(const u32x4*)(src + 1024); } \
        if (wave < 2) { const int d_ = wave, sl_ = d_ ? sl1 : sl0; \
            const int p0 = 2 * lane, p1 = p0 + 1, t0 = d_ ? 127 - p0 : p0, t1 = d_ ? 127 - p1 : p1; \
            gf0 = GATES[(size_t)(rowbase + t0) * 16 + d_ * 8 + 4 + h]; gf1 = GATES[(size_t)(rowbase + t1) * 16 + d_ * 8 + 4 + h]; \
            gi0 = GATES[(size_t)(rowbase + t0) * 16 + d_ * 8 + h]; gi1 = GATES[(size_t)(rowbase + t1) * 16 + d_ * 8 + h]; \
            gmp = sl_ >= 0 ? (lat ? MP[sl_] : SCm[sl_ * 2 + 1]) : -1e30f; gn0 = sl_ >= 0 ? NST[(size_t)sl_ * 128 + lane] : 0.f; gn1 = sl_ >= 0 ? NST[(size_t)sl_ * 128 + 64 + lane] : 0.f; } } while (0)
    int rowbase = 0, h = 0, oc = 0, nc = 2, cbase = 0, sl0 = -1, sl1 = -1; bool lat = false;
    u32x4 rq[4], rk[4], rv[4]; float gf0 = 0.f, gf1 = 0.f, gi0 = 0.f, gi1 = 0.f, gmp = 0.f, gn0 = 0.f, gn1 = 0.f;
    if (u_first >= 0 && u_first < u_end) { M3_DECODE(u_first); M3_LOAD(); }
    for (int u = u_first; u >= 0 && u < u_end; u += u_step) {
        if (wave < 2) {
            const int d = wave;
            const int p0 = 2 * lane, p1 = p0 + 1, t0 = d ? 127 - p0 : p0, t1 = d ? 127 - p1 : p1;
            float b0, b1; scan_add2(gf0, gf1, b0, b1, lane);
            const float a0 = gi0 - b0, a1 = gi1 - b1; float m0, m1; scan_max2(a0, a1, m0, m1, lane);
            ga[d * 128 + t0] = a0; ga[d * 128 + t1] = a1; gc[d * 128 + t0] = fmaxf(gmp, m0); gc[d * 128 + t1] = fmaxf(gmp, m1); gb[d * 128 + t0] = b0; gb[d * 128 + t1] = b1;
            gn[d * 128 + lane] = gn0; gn[d * 128 + 64 + lane] = gn1;
        }
#pragma unroll
        for (int i = 0; i < 4; ++i) { const int id = tid + NT * i, row = id >> 4, ch = id & 15;
            *(u32x4*)(Kt + row * KR_STR + ch * 16) = rk[i]; *(u32x4*)(Vt + row * KT_STR + ch * 16) = rv[i]; *(u32x4*)(Qt + row * KR_STR + ch * 16) = rq[i]; }
        __syncthreads();
        const int c_rowbase = rowbase, c_h = h;
        const int d = wave >> 2, tb = wave & 3, t = tb * 32 + l31, sl = d ? sl1 : sl0;
        const float mprev = sl >= 0 ? (u < 256 ? SCm[sl * 2 + 1] : MP[sl]) : -1e30f;
        const LAS char* qrowp = Qt3 + t * KR_STR + 16 * hh;
        const float c_t = gc[d * 128 + t], b_t = gb[d * 128 + t];
        const float si = sl >= 0 ? __expf(mprev - c_t) : 0.f;
        float qn = 0.f;
        if (sl >= 0) {
#pragma unroll
            for (int ks = 0; ks < 8; ++ks) { const bf16x8 q = *(const LAS bf16x8*)(qrowp + 32 * ks);
#pragma unroll
                for (int j = 0; j < 8; ++j) qn += bf1((bf16_t)q[j]) * gn[d * 128 + 16 * ks + 8 * hh + j]; }
        }
        qn += __shfl_xor(qn, 32);
        f32x16 H[4];
#pragma unroll
        for (int i = 0; i < 4; ++i)
#pragma unroll
            for (int e = 0; e < 16; ++e) H[i][e] = 0.f;
        float denp = 0.f;
        const int sb_lo = d ? tb : 0, sb_hi = d ? 3 : tb;
#pragma unroll 1
        for (int sb = sb_lo; sb <= sb_hi; ++sb) {
            f32x16 S;
#pragma unroll
            for (int e = 0; e < 16; ++e) S[e] = 0.f;
#pragma unroll
            for (int ks = 0; ks < 8; ++ks) { const bf16x8 a = *(const LAS bf16x8*)(Kt3 + (sb * 32 + l31) * KR_STR + (16 * ks + 8 * hh) * 2); S = MFMA32(a, *(const LAS bf16x8*)(qrowp + 32 * ks), S); }
#pragma unroll
            for (int e = 0; e < 16; ++e) { const int st = sb * 32 + crow(e, hh); const bool ok = d ? (st >= t) : (st <= t);
                const float w = ok ? __expf(ga[d * 128 + st] - c_t) : 0.f; const float pv = S[e] * w; denp += pv; S[e] = pv; }
            const bf16x8 pb0 = pack8(S, 0), pb1 = pack8(S, 1);
#pragma unroll
            for (int dvb = 0; dvb < 4; ++dvb) {
                const int r0 = sb * 32 + 4 * hh, c0 = dvb * 32 + 16 * g1;
                const bf16x8 a0 = cat4(tr_read(Vt3 + tr_off(lane, r0, c0)), tr_read(Vt3 + tr_off(lane, r0 + 8, c0)));
                const bf16x8 a1 = cat4(tr_read(Vt3 + tr_off(lane, r0 + 16, c0)), tr_read(Vt3 + tr_off(lane, r0 + 24, c0)));
                H[dvb] = MFMA32(a0, pb0, H[dvb]); H[dvb] = MFMA32(a1, pb1, H[dvb]);
            }
        }
        if (sl >= 0) {
            const bf16_t* ct = SLOT + (size_t)sl * 16384;
#pragma unroll
            for (int ks = 0; ks < 8; ++ks) { u32x4 q = *(const LAS u32x4*)(qrowp + 32 * ks);
                q.x = pk2(bflo(q.x) * si, bfhi(q.x) * si); q.y = pk2(bflo(q.y) * si, bfhi(q.y) * si); q.z = pk2(bflo(q.z) * si, bfhi(q.z) * si); q.w = pk2(bflo(q.w) * si, bfhi(q.w) * si);
                const bf16x8 qs = __builtin_bit_cast(bf16x8, q);
#pragma unroll
                for (int dvb = 0; dvb < 4; ++dvb) { const bf16x8 a = *(const bf16x8*)(ct + (dvb * 32 + l31) * 128 + 16 * ks + 8 * hh); H[dvb] = MFMA32(a, qs, H[dvb]); }
            }
        }
        const float den = si * qn + (denp + __shfl_xor(denp, 32));
        const float inv = 1.f / fmaxf(fabsf(den), __expf(-(c_t + b_t)));
#pragma unroll
        for (int i = 0; i < 4; ++i)
#pragma unroll
            for (int e = 0; e < 16; ++e) H[i][e] *= inv;
        __syncthreads();
        { const int un = u + u_step; if (un < u_end) { M3_DECODE(un); M3_LOAD(); } }
        if (d == 1) {
#pragma unroll
            for (int dvb = 0; dvb < 4; ++dvb)
#pragma unroll
                for (int g = 0; g < 4; ++g) { f32x4 v; v.x = H[dvb][4 * g]; v.y = H[dvb][4 * g + 1]; v.z = H[dvb][4 * g + 2]; v.w = H[dvb][4 * g + 3]; *(f32x4*)(X + t * 132 + dvb * 32 + 8 * g + 4 * hh) = v; }
        }
        __syncthreads();
        if (d == 0) {
            float ss = 0.f;
#pragma unroll
            for (int dvb = 0; dvb < 4; ++dvb)
#pragma unroll
                for (int g = 0; g < 4; ++g) { const f32x4 v = *(const f32x4*)(X + t * 132 + dvb * 32 + 8 * g + 4 * hh);
                    H[dvb][4 * g] += v.x; H[dvb][4 * g + 1] += v.y; H[dvb][4 * g + 2] += v.z; H[dvb][4 * g + 3] += v.w;
                    ss += (H[dvb][4 * g] * H[dvb][4 * g] + H[dvb][4 * g + 1] * H[dvb][4 * g + 1]) + (H[dvb][4 * g + 2] * H[dvb][4 * g + 2] + H[dvb][4 * g + 3] * H[dvb][4 * g + 3]); }
            ss += __shfl_xor(ss, 32);
            const float rstd = rsqrtf(ss * (1.f / 128) + 1e-6f);
#pragma unroll
            for (int dvb = 0; dvb < 4; ++dvb)
#pragma unroll
                for (int g = 0; g < 4; ++g) { const int dv = dvb * 32 + 8 * g + 4 * hh; const f32x4 w = *(const f32x4*)(hn + c_h * 128 + dv);
                    u32x2* mp = (u32x2*)(MO + (size_t)(c_rowbase + t) * 512 + c_h * 128 + dv); const u32x2 mo = *mp;
                    u32x2 o; o.x = pk2(H[dvb][4 * g] * rstd * w.x * bflo(mo.x), H[dvb][4 * g + 1] * rstd * w.y * bfhi(mo.x));
                    o.y = pk2(H[dvb][4 * g + 2] * rstd * w.z * bflo(mo.y), H[dvb][4 * g + 3] * rstd * w.w * bfhi(mo.y)); if (!dry || rstd == 12345.678f) *mp = o; }
        }
        __syncthreads();
    }
}

constexpr int AK_STR = 208;
constexpr int AV_STR = 136;
constexpr int A_KB = 64 * AK_STR, A_VB = 64 * AV_STR;
DI float max3f(float a, float b, float c) { float r; asm("v_max3_f32 %0, %1, %2, %3" : "=v"(r) : "v"(a), "v"(b), "v"(c)); return r; }
struct AStage { u32x4 k0, k1, v; };
DI void phase_attn(const Params& p, unsigned char* lds) {
    const int tid = tid_(), lane = tid & 63, wave = tid >> 6, hh = lane >> 5, l31 = lane & 31;
    unsigned char* ws = lp_(p.ws); unsigned char* dob = (unsigned char*)p.out;
    const bf16_t* Q = (const bf16_t*)(ws + WS_Q); const bf16_t* KN = (const bf16_t*)(ws + WS_KN); const bf16_t* KR = (const bf16_t*)(ws + WS_KR);
    const bf16_t* VT = (const bf16_t*)(dob + DO_VT); bf16_t* AO = (bf16_t*)(dob + DO_AO);
    const LAS char* L3 = (const LAS char*)lds;
    const int id1 = (tid + 512) % 768;
    const int kkey0 = tid / 12, kch0 = tid % 12, kkey1 = id1 / 12, kch1 = id1 % 12;
    const int vdv = tid >> 3, vch = tid & 7;
    for (int u = bid_(); u < 768; u += gridDim.x) {
        int qrow0, keybase, nkt, h;
        if (u < 512) {
            const int r = u >> 8, i = u & 255, xcd = i & 7, slot = i >> 3, bh = r * 16 + xcd * 2 + (slot >> 4), qb = slot & 15; h = bh & 7; const int b = bh >> 3;
            qrow0 = RC + b * 4096 + qb * 256; keybase = RC + b * 4608; nkt = 72; }
        else { const int v = u - 512; h = v & 7; const int b = v >> 3; qrow0 = b * 256; keybase = b * 256; nkt = 4; }
        const int qrow = qrow0 + wave * 32 + l31;
        bf16x8 qf[6];
#pragma unroll
        for (int ks = 0; ks < 6; ++ks) qf[ks] = *(const bf16x8*)(Q + (size_t)qrow * 768 + h * 96 + 16 * ks + 8 * hh);
        f32x16 O[2];
#pragma unroll
        for (int e = 0; e < 16; ++e) { O[0][e] = 0.f; O[1][e] = 0.f; }
        const bf16_t* kp0 = kch0 < 8 ? KN + (size_t)(keybase + kkey0) * 512 + h * 64 + kch0 * 8 : KR + (size_t)(keybase + kkey0) * 32 + (kch0 - 8) * 8;
        const bf16_t* kp1 = kch1 < 8 ? KN + (size_t)(keybase + kkey1) * 512 + h * 64 + kch1 * 8 : KR + (size_t)(keybase + kkey1) * 32 + (kch1 - 8) * 8;
        const int ks0 = kch0 < 8 ? 64 * 512 : 64 * 32, ks1 = kch1 < 8 ? 64 * 512 : 64 * 32;
        const bf16_t* vp0 = VT + (size_t)(h * 64 + vdv) * RK + keybase + vch * 8;
#define K_LOAD(st, kt) do { (st).k0 = *(const u32x4*)(kp0 + (size_t)(kt) * ks0); (st).k1 = *(const u32x4*)(kp1 + (size_t)(kt) * ks1); } while (0)
#define V_LOAD(st, kt) do { (st).v = *(const u32x4*)(vp0 + (kt) * 64); } while (0)
#define K_STORE(st, buf) do { unsigned char* b_ = lds + (buf) * A_KB; *(u32x4*)(b_ + kkey0 * AK_STR + kch0 * 16) = (st).k0; *(u32x4*)(b_ + kkey1 * AK_STR + kch1 * 16) = (st).k1; } while (0)
#define V_STORE(st, buf) do { unsigned char* b_ = lds + 2 * A_KB + (buf) * A_VB; u32x2 lo_, hi_; lo_.x = (st).v.x; lo_.y = (st).v.y; hi_.x = (st).v.z; hi_.y = (st).v.w; \
            *(u32x2*)(b_ + vdv * AV_STR + vch * 16) = lo_; *(u32x2*)(b_ + vdv * AV_STR + vch * 16 + 8) = hi_; } while (0)
#define QK_READ(buf) const LAS char* kb3_ = L3 + (buf) * A_KB; bf16x8 ka0[6], ka1[6]; \
            _Pragma("unroll") for (int ks = 0; ks < 6; ++ks) ka0[ks] = *(const LAS bf16x8*)(kb3_ + l31 * AK_STR + (16 * ks + 8 * hh) * 2); \
            _Pragma("unroll") for (int ks = 0; ks < 6; ++ks) ka1[ks] = *(const LAS bf16x8*)(kb3_ + (32 + l31) * AK_STR + (16 * ks + 8 * hh) * 2);
#define FIXUP(Sx, forced) do { \
            float tm = max3f(Sx[0][0], Sx[1][0], Sx[0][1]); \
            _Pragma("unroll") for (int e = 1; e < 15; e += 2) { tm = max3f(tm, Sx[1][e], Sx[0][e + 1]); tm = max3f(tm, Sx[1][e + 1], Sx[0][e + 2]); } \
            tm = fmaxf(tm, Sx[1][15]); tm = fmaxf(tm, __shfl_xor(tm, 32)); \
            if ((forced) || __builtin_amdgcn_ballot_w64(tm > 8.f) != 0ull) { \
                const float delta = (forced) ? tm : fmaxf(tm, 0.f); const float alpha = __builtin_amdgcn_exp2f(-delta); \
                _Pragma("unroll") for (int e = 0; e < 16; ++e) { Sx[0][e] -= delta; Sx[1][e] -= delta; O[0][e] *= alpha; O[1][e] *= alpha; Ol[e] *= alpha; } \
                mbase += delta; } } while (0)
        AStage RA;
        K_LOAD(RA, 0); V_LOAD(RA, 0); K_STORE(RA, 0); V_STORE(RA, 0);
        K_LOAD(RA, 1);
        __syncthreads();
        f32x16 S[2], Ol; float mbase = 0.f;
        bf16x8 ones;
#pragma unroll
        for (int e = 0; e < 8; ++e) ones[e] = (short)0x3f80;
#pragma unroll
        for (int e = 0; e < 16; ++e) { S[0][e] = 0.f; S[1][e] = 0.f; Ol[e] = 0.f; }
        { QK_READ(0)
#pragma unroll
          for (int ks = 0; ks < 6; ++ks) { S[0] = MFMA32(ka0[ks], qf[ks], S[0]); S[1] = MFMA32(ka1[ks], qf[ks], S[1]); } }
        FIXUP(S, true);
        K_STORE(RA, 1);
        __syncthreads();
        for (int kt = 0; kt < nkt; ++kt) {
            { const int kk = kt + 2 < nkt ? kt + 2 : nkt - 1, kv = kt + 1 < nkt ? kt + 1 : nkt - 1; K_LOAD(RA, kk); V_LOAD(RA, kv); }
            f32x16 Sn[2];
#pragma unroll
            for (int e = 0; e < 16; ++e) { Sn[0][e] = -mbase; Sn[1][e] = -mbase; }
            QK_READ((kt + 1) & 1)
            __builtin_amdgcn_sched_barrier(0);
#pragma unroll
            for (int ks = 0; ks < 6; ++ks) Sn[0] = MFMA32(ka0[ks], qf[ks], Sn[0]);
#pragma unroll
            for (int e = 0; e < 16; ++e) S[0][e] = __builtin_amdgcn_exp2f(S[0][e]);
#pragma unroll
            for (int i2 = 0; i2 < 6; ++i2) { __builtin_amdgcn_sched_group_barrier(0x008, 1, 0); __builtin_amdgcn_sched_group_barrier(0x002, 3, 0); }
            __builtin_amdgcn_sched_barrier(0);
            const LAS char* vb3 = L3 + 2 * A_KB + (kt & 1) * A_VB;
            s16x4 va[2][2][2][2];
#pragma unroll
            for (int dvb = 0; dvb < 2; ++dvb)
#pragma unroll
                for (int kb = 0; kb < 2; ++kb)
#pragma unroll
                    for (int s2 = 0; s2 < 2; ++s2) { const LAS char* vp = vb3 + (dvb * 32 + l31) * AV_STR + (kb * 32 + 16 * s2 + 4 * hh) * 2;
                        va[dvb][kb][s2][0] = *(const LAS s16x4*)vp; va[dvb][kb][s2][1] = *(const LAS s16x4*)(vp + 16); }
            __builtin_amdgcn_sched_barrier(0);
#pragma unroll
            for (int ks = 0; ks < 6; ++ks) Sn[1] = MFMA32(ka1[ks], qf[ks], Sn[1]);
#pragma unroll
            for (int e = 0; e < 16; ++e) S[1][e] = __builtin_amdgcn_exp2f(S[1][e]);
            bf16x8 pb[2][2];
#pragma unroll
            for (int kb = 0; kb < 2; ++kb) { pb[kb][0] = pack8(S[kb], 0); pb[kb][1] = pack8(S[kb], 1); }
#pragma unroll
            for (int i2 = 0; i2 < 6; ++i2) { __builtin_amdgcn_sched_group_barrier(0x008, 1, 0); __builtin_amdgcn_sched_group_barrier(0x002, 6, 0); }
            __builtin_amdgcn_sched_barrier(0);
#pragma unroll
            for (int kb = 0; kb < 2; ++kb)
#pragma unroll
                for (int s2 = 0; s2 < 2; ++s2) {
                    O[0] = MFMA32(cat4(va[0][kb][s2][0], va[0][kb][s2][1]), pb[kb][s2], O[0]);
                    O[1] = MFMA32(cat4(va[1][kb][s2][0], va[1][kb][s2][1]), pb[kb][s2], O[1]);
                    Ol = MFMA32(ones, pb[kb][s2], Ol); }
            K_STORE(RA, kt & 1); V_STORE(RA, (kt + 1) & 1);
            FIXUP(Sn, false);
            __syncthreads();
            S[0] = Sn[0]; S[1] = Sn[1];
        }
#undef QK_READ
#undef FIXUP
#undef K_LOAD
#undef V_LOAD
#undef K_STORE
#undef V_STORE
        const float linv = 1.f / Ol[0];
#pragma unroll
        for (int dvb = 0; dvb < 2; ++dvb)
#pragma unroll
            for (int g = 0; g < 4; ++g) { u32x2 o; o.x = pk2(O[dvb][4 * g] * linv, O[dvb][4 * g + 1] * linv); o.y = pk2(O[dvb][4 * g + 2] * linv, O[dvb][4 * g + 3] * linv);
                *(u32x2*)(AO + (size_t)qrow * 512 + h * 64 + dvb * 32 + 8 * g + 4 * hh) = o; }
    }
}

constexpr size_t WS_BAR = 512 * 1024;
#define XB_TMO      128
#define XB_XCNT(j)  (256  + 64 * (j))
#define XB_XSUB(j)  (1280 + 64 * (j))
#define XB_XGEN(j)  (2304 + 64 * (j))
#define XB_TOP      3328
#define XB_TOPGEN   3392
#define XCD_BAR_WORDS 3456
#define XB_SPIN_CAP (1u << 18)

__device__ __forceinline__ unsigned xb_ld(unsigned* p)              { return __hip_atomic_load(p, __ATOMIC_RELAXED, __HIP_MEMORY_SCOPE_AGENT); }
__device__ __forceinline__ unsigned xb_add(unsigned* p, unsigned v) { return __hip_atomic_fetch_add(p, v, __ATOMIC_RELAXED, __HIP_MEMORY_SCOPE_AGENT); }
__device__ __forceinline__ unsigned xb_xcc_id() { return (unsigned)__builtin_amdgcn_s_getreg((3 << 11) | 20) & 0xFu; }
#define XB_SPIN(cond, bar) do { unsigned _sp = 0; while (cond) { __builtin_amdgcn_s_sleep(1); \
    if ((++_sp & 255u) == 0u) { if (xb_ld(&(bar)[XB_TMO])) break; if (_sp > XB_SPIN_CAP) { atomicAdd(&(bar)[XB_TMO], 1u); break; } } } } while (0)

struct XcdBarrier {
    unsigned* bar; unsigned x;
    volatile LAS unsigned* st;
};

__device__ __forceinline__ XcdBarrier xcd_barrier_post(unsigned* bar, volatile LAS unsigned* st) {
    XcdBarrier b; b.bar = bar; b.x = xb_xcc_id(); b.st = st;
    if (threadIdx.x == 0) (void)xb_add(&bar[XB_XCNT(b.x)], 1u);
    return b;
}
__device__ __forceinline__ void xcd_barrier_complete(unsigned* bar, unsigned x, unsigned& nloc, unsigned& nx) {
    const unsigned G = gridDim.x * gridDim.y * gridDim.z;
    unsigned sum, cnt, mine, sp = 0u;
    for (;;) {
        sum = 0u; cnt = 0u; mine = 0u;
#pragma unroll
        for (unsigned j = 0; j < 16; ++j) { const unsigned c = xb_ld(&bar[XB_XCNT(j)]); sum += c; cnt += (c > 0u) ? 1u : 0u; mine = (j == x) ? c : mine; }
        if (sum == G) break;
        __builtin_amdgcn_s_sleep(1);
        if ((++sp & 255u) == 0u) { if (xb_ld(&bar[XB_TMO])) break; if (sp > XB_SPIN_CAP) { atomicAdd(&bar[XB_TMO], 1u); break; } }
    }
    nloc = mine > 0u ? mine : 1u; nx = cnt > 0u ? cnt : 1u;
}

__device__ __forceinline__ void xcd_barrier(const XcdBarrier& b) {
    asm volatile("s_waitcnt vmcnt(0)" ::: "memory");
    __syncthreads();
    if (threadIdx.x == 0) {
        unsigned* bar = b.bar;
        __builtin_amdgcn_s_waitcnt(0);
        unsigned nloc = b.st[0], nx = b.st[1];
        if (nloc == 0u) { xcd_barrier_complete(bar, b.x, nloc, nx); b.st[0] = nloc; b.st[1] = nx; }
        const unsigned old = xb_add(&bar[XB_XSUB(b.x)], 1u);
        const unsigned gen = old / nloc;
        if (old + 1u == (gen + 1u) * nloc) {
            __builtin_amdgcn_fence(__ATOMIC_RELEASE, "agent");
            asm volatile("s_waitcnt vmcnt(0)" ::: "memory");
            const unsigned og = xb_add(&bar[XB_TOP], 1u);
            const unsigned tg = og / nx;
            if (og + 1u == (tg + 1u) * nx) xb_add(&bar[XB_TOPGEN], 1u);
            else XB_SPIN(xb_ld(&bar[XB_TOPGEN]) == tg, bar);
            __builtin_amdgcn_fence(__ATOMIC_ACQUIRE, "agent");
            xb_add(&bar[XB_XGEN(b.x)], 1u);
            asm volatile("s_waitcnt vmcnt(0)" ::: "memory");
        } else {
            XB_SPIN(xb_ld(&bar[XB_XGEN(b.x)]) == gen, bar);
            __builtin_amdgcn_fence(__ATOMIC_ACQUIRE, "agent");
            asm volatile("s_waitcnt vmcnt(0)" ::: "memory");
        }
    }
    __syncthreads();
}

constexpr int LDS_BYTES = 147456;
constexpr int N_PHASES = 16;
#ifndef PM
#define PM 0x1FFFF
#endif
#define PH(k) ((PM >> (k)) & 1)
#ifndef DUP
#define DUP 0
#endif
#define DP(k) ((DUP >> (k)) & 1)
__global__ void __launch_bounds__(NT, 2) fwd_kernel(Params p_) {
    Params p = p_;
    p.ws = gp_(p_.ws); p.out = gp_(p_.out);
#pragma unroll
    for (int i = 0; i < 27; ++i) p.in[i] = gp_(p_.in[i]);
    extern __shared__ __attribute__((aligned(16))) unsigned char lds[];
    cg::grid_group grid = cg::this_grid();
    unsigned char* ws = lp_(p.ws); unsigned char* dob = (unsigned char*)p.out;
    const int lo = p.ph_lo, hi = p.ph_hi;
    unsigned* barw = (unsigned*)(ws + WS_BAR);
    volatile LAS unsigned* xst = (volatile LAS unsigned*)((LAS unsigned char*)lds + (LDS_BYTES - 64));
    if (tid_() == 0) { xst[0] = 0u; xst[1] = 0u; }
    if (blockIdx.x == 0) { for (int i = tid_(); i < XCD_BAR_WORDS; i += NT) __hip_atomic_store(barw + i, 0u, __ATOMIC_RELAXED, __HIP_MEMORY_SCOPE_AGENT); }
    XcdBarrier xbar; xbar.bar = barw; xbar.x = 0; xbar.st = xst;
#define GSYNC(k) do { if ((k) == lo + 2) { grid.sync(); xbar = xcd_barrier_post(barw, xst); } else xcd_barrier(xbar); } while (0)
#define IN(k) (lo <= (k) && (k) < hi)
#define SEAM(k) do { if (IN(k) && (k) > lo) GSYNC(k); } while (0)
#define RUN_GEMMS(G0, G1) do { if (PH(16)) for (int gi = (G0); gi < (G1); ++gi) { \
            pg8::Gemm g; EpiGen E; E.ws = ws; E.dout = p.out; E.gate_b = p.in[16]; E.ldc = 0; E.hstride = 0; E.out = ws; E.mode = EM_BF16; int boff = 0; \
            const bf16_t* H2 = (const bf16_t*)(ws + WS_H2); \
            switch (gi) { \
            case 0: g = {(const bf16_t*)(dob + DO_H1), (const bf16_t*)(ws + WS_WIN), R, NIN, 1024}; E.mode = EM_IN; break; \
            case 1: g = {(const bf16_t*)(ws + WS_CQ), (const bf16_t*)(ws + WS_WUQ), R, 768, 384}; E.mode = EM_Q; E.out = ws + WS_Q; break; \
            case 2: g = {(const bf16_t*)(dob + DO_KC), (const bf16_t*)(ws + WS_WUK), RK, 512, 256}; E.mode = EM_BF16; E.out = ws + WS_KN; E.ldc = 512; boff = 224; break; \
            case 3: g = {(const bf16_t*)(ws + WS_WV), (const bf16_t*)(dob + DO_KC), 512, RK, 256}; E.mode = EM_BF16; E.out = dob + DO_VT; E.ldc = RK; boff = 208; break; \
            case 4: g = {(const bf16_t*)(ws + WS_MO), (const bf16_t*)(ws + WS_WOM), R, 1024, 512}; E.mode = EM_G1; E.out = ws + WS_Z; break; \
            case 5: g = {(const bf16_t*)(dob + DO_AO), (const bf16_t*)(ws + WS_WOA), R, 1024, 512}; E.mode = EM_G2; E.out = ws + WS_Z; break; \
            case 6: g = {(const bf16_t*)(ws + WS_Z), (const bf16_t*)(ws + WS_WOUT), R, 1024, 1024}; E.mode = EM_BF16; E.out = ws + WS_MG; E.ldc = 1024; break; \
            case 7: g = {H2 + (size_t)RA_ROWS * 1024, (const bf16_t*)(ws + WS_W1), RB_ROWS, 4096, 1024}; E.mode = EM_RELU2; E.out = ws + WS_F1; E.hstride = (size_t)RB_ROWS * 2048; break; \
            case 8: g = {(const bf16_t*)(ws + WS_F1), (const bf16_t*)(ws + WS_W2), RB_ROWS, 1024, 2048}; E.mode = EM_BF16; E.out = ws + WS_P0; E.ldc = 1024; break; \
            case 9: g = {(const bf16_t*)(ws + WS_F1) + (size_t)RB_ROWS * 2048, (const bf16_t*)(ws + WS_W2) + (size_t)1024 * 2048, RB_ROWS, 1024, 2048}; E.mode = EM_BF16; E.out = ws + WS_P1; E.ldc = 1024; boff = 128; break; \
            case 10: g = {H2, (const bf16_t*)(ws + WS_W1), RA_ROWS, 4096, 1024}; E.mode = EM_RELU2; E.out = ws + WS_F1; E.hstride = (size_t)RA_ROWS * 2048; break; \
            case 11: g = {(const bf16_t*)(ws + WS_F1), (const bf16_t*)(ws + WS_W2), RA_ROWS, 1024, 2048}; E.mode = EM_BF16; E.out = ws + WS_P0; E.ldc = 1024; break; \
            default: g = {(const bf16_t*)(ws + WS_F1) + (size_t)RA_ROWS * 2048, (const bf16_t*)(ws + WS_W2) + (size_t)1024 * 2048, RA_ROWS, 1024, 2048}; E.mode = EM_ADD; E.out = ws + WS_P0; E.ldc = 1024; break; \
            } \
            __syncthreads(); \
            pg8::StaticOrder S; S.init(g.M, g.N, (int)gridDim.x, (bid_() + boff) % (int)gridDim.x); \
            pg8::gemm_phase<EpiGen, pg8::StaticOrder, true, true>((PG8_LAS unsigned char*)lds, g, S, E); \
            __syncthreads(); \
        } } while (0)
    if (IN(0)) { if (PH(0)) { phase_A(p, lds, false); __syncthreads(); phase_A(p, lds, true); } if (IN(1) && PH(1)) { __syncthreads(); phase_B(p); } }
    if (IN(1) && !IN(0)) { if (PH(1)) phase_B(p); }
    if (DP(20)) { for (int i = 0; i < 10; ++i) xcd_barrier(xbar); }
    SEAM(2); if (IN(2)) { RUN_GEMMS(0, 1); if (DP(2)) RUN_GEMMS(0, 1); }
    SEAM(3); if (IN(3)) { if (PH(3)) { phase_M1(p, lds); if (DP(3)) phase_M1(p, lds); phase_D(p); } }
    SEAM(4); if (IN(4)) { if (PH(4)) { phase_M2(p, lds); __syncthreads(); phase_M3(p, lds, false, bid_() >= 128 ? bid_() - 128 : -1, 256, 128); } }
    SEAM(5); if (IN(5)) { if (PH(5)) phase_M3(p, lds, false, 256 + bid_(), 768, (int)gridDim.x); }
    SEAM(6); if (IN(6)) { RUN_GEMMS(1, 4); if (DP(6)) RUN_GEMMS(1, 4); }
    SEAM(7); if (IN(7)) { if (PH(7)) phase_attn(p, lds); if (DP(7)) phase_attn(p, lds); }
    for (int ph = (lo > 8 ? lo : 8); ph < hi; ++ph) {
        if (ph > lo) GSYNC(ph);
        int g0 = 0, g1 = 0;
        switch (ph) {
        case 8: g0 = 4; g1 = 6; break;
        case 9: g0 = 6; g1 = 7; break;
        case 10: if (PH(10)) phase_I(p); if (DP(10)) phase_I(p); break;
        case 11: g0 = 7; g1 = 8; break;
        case 12: g0 = 8; g1 = 10; break;
        case 13: if (DP(21)) phase_L(p, RA_ROWS, RB_ROWS, (const bf16_t*)(ws + WS_P0), (const bf16_t*)(ws + WS_P1), true);
                 if (PH(13)) phase_L(p, RA_ROWS, RB_ROWS, (const bf16_t*)(ws + WS_P0), (const bf16_t*)(ws + WS_P1)); g0 = 10; g1 = 11; break;
        case 14: g0 = 11; g1 = 13; break;
        case 15: if (DP(21)) phase_L(p, 0, RA_ROWS, (const bf16_t*)(ws + WS_P0), nullptr, true);
                 if (PH(15)) phase_L(p, 0, RA_ROWS, (const bf16_t*)(ws + WS_P0), nullptr); break;
        }
        RUN_GEMMS(g0, g1);
        if ((DUP >> ph) & 1) RUN_GEMMS(g0, g1);
    }
}

extern "C" void kernel_launch(void* const* d_in, const int* in_sizes, int n_in, void* d_out, int out_size, void* d_ws, size_t ws_size, hipStream_t stream) {
    static int grid = 0;
    if (grid == 0) {
        int dev = 0, cus = 0, per_cu = 0;
        hipGetDevice(&dev); hipDeviceGetAttribute(&cus, hipDeviceAttributeMultiprocessorCount, dev);
        if (hipFuncSetAttribute((const void*)fwd_kernel, hipFuncAttributeMaxDynamicSharedMemorySize, LDS_BYTES) != hipSuccess) fprintf(stderr, "kernel_launch: hipFuncSetAttribute failed\n");
        if (hipOccupancyMaxActiveBlocksPerMultiprocessor(&per_cu, (const void*)fwd_kernel, NT, LDS_BYTES) != hipSuccess || per_cu < 1) { fprintf(stderr, "kernel_launch: occupancy query says %d\n", per_cu); per_cu = 1; }
        (void)hipGetLastError();
        grid = cus * 1;
        if (n_in != 27 || ws_size < WS_END) fprintf(stderr, "kernel_launch: unexpected n_in %d / ws_size %zu\n", n_in, ws_size);
    }
    (void)hipMemsetAsync((unsigned char*)d_ws + WS_ADACNT, 0, 256, stream);
    Params p{};
    for (int i = 0; i < 27; ++i) p.in[i] = (const float*)d_in[i];
    p.out = (float*)d_out; p.ws = (unsigned char*)d_ws;
#ifndef MK_SPLIT
    p.ph_lo = 0; p.ph_hi = N_PHASES;
    void* args[] = {&p};
    hipError_t e = hipLaunchCooperativeKernel((const void*)fwd_kernel, dim3(grid), dim3(NT), args, LDS_BYTES, stream);
    if (e != hipSuccess) fprintf(stderr, "cooperative launch failed: %s (grid %d)\n", hipGetErrorString(e), grid);
#else
    for (int ph = 0; ph < N_PHASES; ++ph) { p.ph_lo = ph; p.ph_hi = ph + 1; hipLaunchKernelGGL(fwd_kernel, dim3(grid), dim3(NT), LDS_BYTES, stream, p); }
#endif
}
```
